# Optimizing an MI355X kernel written in HIP

```python
import math
import jax, jax.numpy as jnp
from jax import lax
import numpy as np

D_MODEL = 2048
BATCH = 4
SEQ = 2048
DEPTH = 4

EPS = 1e-6
PLE_DIM = 256
SSD_EXPAND = 2
SSD_INNER = SSD_EXPAND * D_MODEL
SSD_HEAD_DIM = 64
SSD_HEADS = SSD_INNER // SSD_HEAD_DIM
SSD_GROUPS = 8
SSD_STATE = 128
SSD_CONV = 4
SSD_CHUNK = 128
SSD_XBC = SSD_INNER + 2 * SSD_GROUPS * SSD_STATE
SC_WIDTH = D_MODEL
SC_CONV = 3
D_FF = int(math.ceil(8 * D_MODEL / 3 / 256) * 256)
IN_SPLITS = (
    SSD_INNER,
    SSD_XBC,
    SSD_HEADS,
    SC_WIDTH,
    SC_WIDTH,
    SC_WIDTH,
    D_MODEL,
    D_MODEL,
)
D_IN = sum(IN_SPLITS)

kernel_name = "hybrid_ssd_shortconv_gated_trunk"


def rmsnorm(x, g):
    xf = x.astype(jnp.float32)
    y = xf * lax.rsqrt(jnp.mean(xf * xf, axis=-1, keepdims=True) + EPS) * g.astype(jnp.float32)
    return y.astype(x.dtype)


def causal_dwconv(x, w):
    k_w = w.shape[0]
    t = x.shape[1]
    xp = jnp.pad(x, ((0, 0), (k_w - 1, 0), (0, 0)))
    out = xp[:, 0:t, :] * w[0]
    for k in range(1, k_w):
        out = out + xp[:, k:k + t, :] * w[k]
    return out


def split_cols(y, sizes):
    idx = np.cumsum(np.array(sizes))[:-1].tolist()
    return jnp.split(y, idx, axis=-1)


def ssd_chunked(xh, dt, a, bm, cm):
    b, t, h, p = xh.shape
    g, n = bm.shape[2], bm.shape[3]
    r = h // g
    c = t // SSD_CHUNK
    L = SSD_CHUNK
    x = (xh.astype(jnp.float32) * dt[..., None]).reshape(b, c, L, g, r, p)
    adt = (dt * a).reshape(b, c, L, g, r).transpose(0, 3, 4, 1, 2)
    acs = jnp.cumsum(adt, axis=-1)
    B = bm.astype(jnp.float32).reshape(b, c, L, g, n)
    C = cm.astype(jnp.float32).reshape(b, c, L, g, n)
    mask = jnp.tril(jnp.ones((L, L), dtype=bool))
    seg = acs[..., :, None] - acs[..., None, :]
    decay = jnp.exp(jnp.where(mask, seg, -jnp.inf))
    cb = jnp.einsum('bclgn,bcsgn->bgcls', C, B)
    y_diag = jnp.einsum('bgcls,bgrcls,bcsgrp->bclgrp', cb, decay, x)
    decay_states = jnp.exp(acs[..., -1:] - acs)
    states = jnp.einsum('bclgn,bgrcl,bclgrp->cbgrpn', B, decay_states, x)
    chunk_decay = jnp.exp(acs[..., -1]).transpose(3, 0, 1, 2)

    def step(s, inp):
        st, dec = inp
        return s * dec[..., None, None] + st, s

    init = jnp.zeros((b, g, r, p, n), jnp.float32)
    _, prev_states = lax.scan(step, init, (states, chunk_decay))
    y_off = jnp.einsum('bclgn,cbgrpn,bgrcl->bclgrp', C, prev_states, jnp.exp(acs))
    return (y_diag + y_off).reshape(b, t, h, p)


def ssd_branch(z, xbc, dt_raw, conv_w, conv_b, dt_bias, a_log, d_skip, norm_w, w_out):
    b, t, _ = z.shape
    xbc = jax.nn.silu(causal_dwconv(xbc, conv_w) + conv_b)
    xs, bm, cm = split_cols(xbc, (SSD_INNER, SSD_GROUPS * SSD_STATE, SSD_GROUPS * SSD_STATE))
    xh = xs.reshape(b, t, SSD_HEADS, SSD_HEAD_DIM)
    bm = bm.reshape(b, t, SSD_GROUPS, SSD_STATE)
    cm = cm.reshape(b, t, SSD_GROUPS, SSD_STATE)
    dt = jax.nn.softplus(dt_raw.astype(jnp.float32) + dt_bias.astype(jnp.float32))
    a = -jnp.exp(a_log.astype(jnp.float32))
    y = ssd_chunked(xh, dt, a, bm, cm) + d_skip.astype(jnp.float32)[:, None] * xh.astype(jnp.float32)
    y = y.reshape(b, t, SSD_INNER) * jax.nn.silu(z.astype(jnp.float32))
    yg = y.reshape(b, t, SSD_GROUPS, SSD_INNER // SSD_GROUPS)
    yg = yg * lax.rsqrt(jnp.mean(yg * yg, axis=-1, keepdims=True) + EPS)
    y = (yg.reshape(b, t, SSD_INNER) * norm_w.astype(jnp.float32)).astype(z.dtype)
    return y @ w_out


def shortconv_branch(gb, gc, xt, conv_w, w_out):
    y = gc * causal_dwconv(gb * xt, conv_w)
    return y @ w_out


def setup_inputs(seed: int = 0) -> dict:
    key = jax.random.key(seed)
    ks = jax.random.split(key, 24)

    def nrm(k, shape, scale):
        return jax.random.normal(k, shape, jnp.float32) * scale

    res_scale = 1.0 / math.sqrt(2 * DEPTH)
    dt0 = jnp.exp(jax.random.uniform(ks[10], (DEPTH, SSD_HEADS), jnp.float32,
                                     math.log(1e-3), math.log(1e-1)))
    dt_bias = dt0 + jnp.log(-jnp.expm1(-dt0))
    return {
        "x": nrm(ks[0], (BATCH, SEQ, D_MODEL), 1.0),
        "p": nrm(ks[1], (DEPTH, BATCH, SEQ, PLE_DIM), 1.0),
        "norm_mix": 1.0 + nrm(ks[2], (DEPTH, D_MODEL), 0.02),
        "w_in": nrm(ks[3], (DEPTH, D_MODEL, D_IN), D_MODEL ** -0.5),
        "ssd_conv_w": nrm(ks[4], (DEPTH, SSD_CONV, SSD_XBC), SSD_CONV ** -0.5),
        "ssd_conv_b": nrm(ks[5], (DEPTH, SSD_XBC), 0.02),
        "ssd_dt_bias": dt_bias,
        "ssd_a_log": jnp.log(jax.random.uniform(ks[6], (DEPTH, SSD_HEADS), jnp.float32, 1.0, 16.0)),
        "ssd_d": 1.0 + nrm(ks[7], (DEPTH, SSD_HEADS), 0.02),
        "ssd_norm": 1.0 + nrm(ks[8], (DEPTH, SSD_INNER), 0.02),
        "ssd_out": nrm(ks[9], (DEPTH, SSD_INNER, D_MODEL), SSD_INNER ** -0.5),
        "sc_conv_w": nrm(ks[11], (DEPTH, SC_CONV, SC_WIDTH), SC_CONV ** -0.5),
        "sc_out": nrm(ks[12], (DEPTH, SC_WIDTH, D_MODEL), SC_WIDTH ** -0.5),
        "w_o": nrm(ks[13], (DEPTH, D_MODEL, D_MODEL), D_MODEL ** -0.5 * res_scale),
        "norm_ffn": 1.0 + nrm(ks[14], (DEPTH, D_MODEL), 0.02),
        "w_gate_up": nrm(ks[15], (DEPTH, D_MODEL, 2 * D_FF), D_MODEL ** -0.5),
        "w_down": nrm(ks[16], (DEPTH, D_FF, D_MODEL), D_FF ** -0.5 * res_scale),
        "norm_ple": 1.0 + nrm(ks[17], (DEPTH, D_MODEL), 0.02),
        "ple_gate": nrm(ks[18], (DEPTH, D_MODEL, D_MODEL), D_MODEL ** -0.5),
        "ple_proj": nrm(ks[19], (DEPTH, PLE_DIM, D_MODEL), PLE_DIM ** -0.5 * res_scale),
        "norm_final": 1.0 + nrm(ks[20], (D_MODEL,), 0.02),
    }


def reference(x, p, norm_mix, w_in, ssd_conv_w, ssd_conv_b, ssd_dt_bias, ssd_a_log, ssd_d,
              ssd_norm, ssd_out, sc_conv_w, sc_out, w_o, norm_ffn, w_gate_up, w_down,
              norm_ple, ple_gate, ple_proj, norm_final):
    h = x
    for i in range(DEPTH):
        u = rmsnorm(h, norm_mix[i])
        proj = u @ w_in[i]
        z, xbc, dt_raw, sc_b, sc_c, sc_x, g_a, g_b = split_cols(proj, IN_SPLITS)
        y_a = ssd_branch(z, xbc, dt_raw, ssd_conv_w[i], ssd_conv_b[i], ssd_dt_bias[i],
                         ssd_a_log[i], ssd_d[i], ssd_norm[i], ssd_out[i])
        y_b = shortconv_branch(sc_b, sc_c, sc_x, sc_conv_w[i], sc_out[i])
        merged = jax.nn.sigmoid(g_a) * y_a + jax.nn.sigmoid(g_b) * y_b
        h = h + merged @ w_o[i]
        v = rmsnorm(h, norm_ffn[i])
        gate, up = jnp.split(v @ w_gate_up[i], 2, axis=-1)
        h = h + (jax.nn.silu(gate) * up) @ w_down[i]
        e = p[i] @ ple_proj[i]
        pg = jax.nn.sigmoid(rmsnorm(h, norm_ple[i]) @ ple_gate[i])
        h = h + pg * e
    return rmsnorm(h, norm_final)
```

```cpp
#include <hip/hip_runtime.h>
#include <cstdio>
#include <cstdint>
namespace pg8 {
#define PG8_LAS __attribute__((address_space(3)))
typedef unsigned short bf16_t;
typedef short bf16x8 __attribute__((ext_vector_type(8)));
typedef float f32x4 __attribute__((ext_vector_type(4)));
typedef unsigned u32x4 __attribute__((ext_vector_type(4)));
constexpr int BM = 256, BK = 64, HALF = 128, HTB = HALF * BK * 2  , STAGE_BYTES = 8 * HTB, NXCD = 8, WGM = 8;

__host__ __device__ __forceinline__ int lds_byte(int r, int c) { const int st = (r >> 4) * 2 + (c >> 5), rr = r & 15, cc = c & 31, ob = rr * 64 + cc * 2; return st * 1024 + (ob ^ (((ob >> 9) & 1) << 5)); }
__host__ __device__ __forceinline__ void stage_rc(int b, int& R, int& C) { const int st = b / 1024, sb = b % 1024, swz = sb ^ (((sb >> 9) & 1) << 5); R = (st >> 1) * 16 + swz / 64; C = (st & 1) * 32 + (swz % 64) / 2; }
__host__ __device__ __forceinline__ int perm32(int rho) { const int n = rho >> 4, i = rho & 15; return 8 * (i >> 2) + 4 * n + (i & 3); }

struct Unit { int pm, pn; };
struct Gemm { const bf16_t* A; const bf16_t* Bt; int M, N, K; };

struct StaticOrder {
    int nM, nN, nwg, G, c;
    __host__ __device__ void init(int M, int N, int G_, int c_) { nM = M / BM; nN = N / BM; nwg = nM * nN; G = G_; c = c_; }
    __host__ __device__ bool next(int i, Unit& u) const {
        const long L = (long)i * G + c; if (L >= nwg) return false;
        int wgid = (int)L; { const int q = nwg / NXCD, r = nwg % NXCD, xcd = wgid % NXCD, off = wgid / NXCD; wgid = (xcd < r ? xcd * (q + 1) : r * (q + 1) + (xcd - r) * q) + off; }
        const int nig = WGM * nN, gid = wgid / nig, fm = gid * WGM, gsz = (nM - fm) < WGM ? (nM - fm) : WGM;
        u.pm = fm + ((wgid % nig) % gsz); u.pn = (wgid % nig) / gsz; return true;
    }
    __device__ __forceinline__ void a_ready(const Unit&) const {}
    __device__ __forceinline__ void done(const Unit&) const {}
};

__device__ __forceinline__ unsigned cvt_pk_bf16(float lo, float hi) { unsigned r; asm volatile("v_cvt_pk_bf16_f32 %0, %1, %2" : "=v"(r) : "v"(lo), "v"(hi)); return r; }
typedef unsigned u32x2 __attribute__((ext_vector_type(2)));
__device__ __forceinline__ float bf_lo(unsigned w) { return __uint_as_float(w << 16); }
__device__ __forceinline__ float bf_hi(unsigned w) { return __uint_as_float(w & 0xffff0000u); }
__device__ __forceinline__ float sigmoidf_fast(float x) { return __builtin_amdgcn_rcpf(1.0f + __expf(-x)); }
__device__ __forceinline__ float siluf_fast(float x) { return x * sigmoidf_fast(x); }

struct EpiStoreBf16 {
    static constexpr bool PERM = true, AFTER_DRAIN = false;
    bf16_t* O; int ldc;
    __device__ __forceinline__ void operator()(const f32x4 (&acc)[2][2][4][2], const Unit& u, int wr, int wc, int fr, int fq) const {
        const int row0 = u.pm * BM + wr * 64 + fr, col0 = u.pn * BM + wc * 32 + 8 * fq;
#pragma unroll
        for (int ai = 0; ai < 2; ++ai)
#pragma unroll
            for (int m = 0; m < 4; ++m) { bf16_t* rowp = O + (size_t)(row0 + ai * HALF + m * 16) * ldc + col0;
#pragma unroll
                for (int bj = 0; bj < 2; ++bj) { const f32x4 v0 = acc[ai][bj][m][0], v1 = acc[ai][bj][m][1];
                    u32x4 w; w.x = cvt_pk_bf16(v0[0], v0[1]); w.y = cvt_pk_bf16(v0[2], v0[3]); w.z = cvt_pk_bf16(v1[0], v1[1]); w.w = cvt_pk_bf16(v1[2], v1[3]);
                    *(u32x4*)(rowp + bj * HALF) = w; } }
    }
};
struct EpiGateMulF32 {
    static constexpr bool PERM = false, AFTER_DRAIN = false;
    float* T; int ldt; const bf16_t* G; int ldg;
    __device__ __forceinline__ void operator()(const f32x4 (&acc)[2][2][4][2], const Unit& u, int wr, int wc, int fr, int fq) const {
        const int row0 = u.pm * BM + wr * 64 + fr, col0 = u.pn * BM + wc * 32 + 4 * fq;
#pragma unroll
        for (int ai = 0; ai < 2; ++ai)
#pragma unroll
            for (int m = 0; m < 4; ++m) { const size_t r = (size_t)(row0 + ai * HALF + m * 16);
#pragma unroll
                for (int bj = 0; bj < 2; ++bj)
#pragma unroll
                    for (int n = 0; n < 2; ++n) { const int c = col0 + bj * HALF + n * 16;
                        const u32x2 gw = *(const u32x2*)(G + r * ldg + c); const f32x4 a = acc[ai][bj][m][n];
                        f32x4 o; o[0] = sigmoidf_fast(bf_lo(gw.x)) * a[0]; o[1] = sigmoidf_fast(bf_hi(gw.x)) * a[1]; o[2] = sigmoidf_fast(bf_lo(gw.y)) * a[2]; o[3] = sigmoidf_fast(bf_hi(gw.y)) * a[3];
                        *(f32x4*)(T + r * ldt + c) = o; }
                asm volatile("" ::: "memory"); }
    }
};
struct EpiGateAddBf16 {
    static constexpr bool PERM = false, AFTER_DRAIN = false;
    const float* T; int ldt; const bf16_t* G; int ldg; bf16_t* O; int ldo;
    __device__ __forceinline__ void operator()(const f32x4 (&acc)[2][2][4][2], const Unit& u, int wr, int wc, int fr, int fq) const {
        const int row0 = u.pm * BM + wr * 64 + fr, col0 = u.pn * BM + wc * 32 + 4 * fq;
#pragma unroll
        for (int ai = 0; ai < 2; ++ai)
#pragma unroll
            for (int m = 0; m < 4; ++m) { const size_t r = (size_t)(row0 + ai * HALF + m * 16);
#pragma unroll
                for (int bj = 0; bj < 2; ++bj)
#pragma unroll
                    for (int n = 0; n < 2; ++n) { const int c = col0 + bj * HALF + n * 16;
                        const u32x2 gw = *(const u32x2*)(G + r * ldg + c); const f32x4 t = *(const f32x4*)(T + r * ldt + c); const f32x4 a = acc[ai][bj][m][n];
                        const float o0 = t[0] + sigmoidf_fast(bf_lo(gw.x)) * a[0], o1 = t[1] + sigmoidf_fast(bf_hi(gw.x)) * a[1], o2 = t[2] + sigmoidf_fast(bf_lo(gw.y)) * a[2], o3 = t[3] + sigmoidf_fast(bf_hi(gw.y)) * a[3];
                        u32x2 w; w.x = cvt_pk_bf16(o0, o1); w.y = cvt_pk_bf16(o2, o3);
                        *(u32x2*)(O + r * ldo + c) = w; }
                asm volatile("" ::: "memory"); }
    }
};
struct EpiResidF32 {
    static constexpr bool PERM = false, AFTER_DRAIN = false;
    const float* Hin; float* Hout; int ld;
    __device__ __forceinline__ void operator()(const f32x4 (&acc)[2][2][4][2], const Unit& u, int wr, int wc, int fr, int fq) const {
        const int row0 = u.pm * BM + wr * 64 + fr, col0 = u.pn * BM + wc * 32 + 4 * fq;
#pragma unroll
        for (int ai = 0; ai < 2; ++ai)
#pragma unroll
            for (int m = 0; m < 4; ++m) { const size_t off = (size_t)(row0 + ai * HALF + m * 16) * ld + col0;
#pragma unroll
                for (int bj = 0; bj < 2; ++bj)
#pragma unroll
                    for (int n = 0; n < 2; ++n) { const f32x4 hv = *(const f32x4*)(Hin + off + bj * HALF + n * 16);
                        *(f32x4*)(Hout + off + bj * HALF + n * 16) = hv + acc[ai][bj][m][n]; }
                asm volatile("" ::: "memory"); }
    }
};
struct EpiSwiGLU {
    static constexpr bool PERM = false, AFTER_DRAIN = false;
    bf16_t* O; int ldo;
    __device__ __forceinline__ void operator()(const f32x4 (&acc)[2][2][4][2], const Unit& u, int wr, int wc, int fr, int fq) const {
        const int row0 = u.pm * BM + wr * 64 + fr, col0 = u.pn * HALF + wc * 16 + 4 * fq;
#pragma unroll
        for (int ai = 0; ai < 2; ++ai)
#pragma unroll
            for (int m = 0; m < 4; ++m) { const size_t r = (size_t)(row0 + ai * HALF + m * 16);
#pragma unroll
                for (int bj = 0; bj < 2; ++bj) { const f32x4 g = acc[ai][bj][m][0], up = acc[ai][bj][m][1];
                    u32x2 w; w.x = cvt_pk_bf16(siluf_fast(g[0]) * up[0], siluf_fast(g[1]) * up[1]); w.y = cvt_pk_bf16(siluf_fast(g[2]) * up[2], siluf_fast(g[3]) * up[3]);
                    *(u32x2*)(O + r * ldo + col0 + bj * 64) = w; } }
    }
};
struct EpiPle {
    static constexpr bool PERM = false, AFTER_DRAIN = false;
    float* H; const bf16_t* E; int ld;
    __device__ __forceinline__ void operator()(const f32x4 (&acc)[2][2][4][2], const Unit& u, int wr, int wc, int fr, int fq) const {
        const int row0 = u.pm * BM + wr * 64 + fr, col0 = u.pn * BM + wc * 32 + 4 * fq;
#pragma unroll
        for (int ai = 0; ai < 2; ++ai)
#pragma unroll
            for (int m = 0; m < 4; ++m) { const size_t off = (size_t)(row0 + ai * HALF + m * 16) * ld + col0;
#pragma unroll
                for (int bj = 0; bj < 2; ++bj)
#pragma unroll
                    for (int n = 0; n < 2; ++n) { const size_t o = off + bj * HALF + n * 16;
                        const u32x2 ew = *(const u32x2*)(E + o); const f32x4 hv = *(const f32x4*)(H + o); const f32x4 a = acc[ai][bj][m][n];
                        f32x4 r; r[0] = hv[0] + sigmoidf_fast(a[0]) * bf_lo(ew.x); r[1] = hv[1] + sigmoidf_fast(a[1]) * bf_hi(ew.x); r[2] = hv[2] + sigmoidf_fast(a[2]) * bf_lo(ew.y); r[3] = hv[3] + sigmoidf_fast(a[3]) * bf_hi(ew.y);
                        *(f32x4*)(H + o) = r; }
                asm volatile("" ::: "memory"); }
    }
};

template <class Epi, class Sched, bool ALIGN_EPI = false, bool SP2 = false>
__device__ __forceinline__ void gemm_phase(PG8_LAS unsigned char* lds, const Gemm g, const Sched& S, const Epi& E, const int tid_in) {
    const int tid = tid_in, wid = __builtin_amdgcn_readfirstlane(tid >> 6), lane = tid & 63, wr = wid >> 2, wc = wid & 3, fr = lane & 15, fq = lane >> 4;
    const int K = g.K, nt = K / BK;
    unsigned voffA[2], voffB[2];
#pragma unroll
    for (int i = 0; i < 2; ++i) { int R, C; stage_rc(tid * 16 + i * 8192, R, C); const int Rb = Epi::PERM ? ((R & ~31) + perm32(R & 31)) : R;
        voffA[i] = (unsigned)(R * K + C) * 2u; voffB[i] = (unsigned)(Rb * K + C) * 2u; }
    const size_t kstep = (size_t)(BK * 2);
    const size_t hstep = (size_t)HALF * K * 2;
    const size_t tstep = 2 * hstep;
    const unsigned ldsw = (unsigned)wid * 1024u;
    const int aoff = lds_byte(wr * 64 + fr, fq * 8), boff = lds_byte(wc * 32 + fr, fq * 8);
#define PG8_SA(b, h) (((b) * 2 + (h)) * HTB)
#define PG8_SB(b, h) ((4 + (b) * 2 + (h)) * HTB)
#define PG8_STAGE(bufoff, gbase, voff) do { _Pragma("unroll") for (int _i = 0; _i < 2; ++_i) \
        __builtin_amdgcn_global_load_lds((const unsigned*)((const char*)(gbase) + (voff)[_i]), (PG8_LAS unsigned*)(lds + (bufoff) + ldsw + _i * 8192), 16, 0, 0); } while (0)
#define PG8_LDA(dst, b, h) do { _Pragma("unroll") for (int m = 0; m < 4; ++m) _Pragma("unroll") for (int k = 0; k < 2; ++k) dst[m][k] = *(const PG8_LAS bf16x8*)(lds + PG8_SA(b, h) + aoff + m * 2048 + k * 1024); } while (0)
#define PG8_LDB(dst, b, h) do { _Pragma("unroll") for (int n = 0; n < 2; ++n) _Pragma("unroll") for (int k = 0; k < 2; ++k) dst[n][k] = *(const PG8_LAS bf16x8*)(lds + PG8_SB(b, h) + boff + n * 2048 + k * 1024); } while (0)
#define PG8_MMA(ai, bj, At, Bt) do { __builtin_amdgcn_s_setprio(1); _Pragma("unroll") for (int m = 0; m < 4; ++m) _Pragma("unroll") for (int n = 0; n < 2; ++n) _Pragma("unroll") for (int k = 0; k < 2; ++k) \
        acc[ai][bj][m][n] = __builtin_amdgcn_mfma_f32_16x16x32_bf16(Bt[n][k], At[m][k], acc[ai][bj][m][n], 0, 0, 0); __builtin_amdgcn_s_setprio(0); } while (0)
#define PG8_WAIT_V(n) asm volatile("s_waitcnt vmcnt(" #n ")" ::: "memory")
#define PG8_WAIT_L(n) asm volatile("s_waitcnt lgkmcnt(" #n ")" ::: "memory")
#define PG8_BAR __builtin_amdgcn_s_barrier()
#define PG8_SCHED __builtin_amdgcn_sched_barrier(0)
    Unit cur, nxt; int ui = 0;
    if (!S.next(0, cur)) return;
    f32x4 acc[2][2][4][2];
#pragma unroll
    for (int a = 0; a < 2; ++a)
#pragma unroll
        for (int b = 0; b < 2; ++b)
#pragma unroll
            for (int m = 0; m < 4; ++m)
#pragma unroll
                for (int n = 0; n < 2; ++n) acc[a][b][m][n] = (f32x4){0.f, 0.f, 0.f, 0.f};
    bf16x8 At[4][2], B0[2][2], B1[2][2];
    const char* cA = (const char*)g.A + (size_t)cur.pm * tstep; const char* cB = (const char*)g.Bt + (size_t)cur.pn * tstep;
    S.a_ready(cur);
    if constexpr (SP2) {
        PG8_STAGE(PG8_SB(0, 0), cB, voffB); PG8_STAGE(PG8_SB(0, 1), cB + hstep, voffB); PG8_STAGE(PG8_SA(0, 0), cA, voffA); PG8_STAGE(PG8_SA(0, 1), cA + hstep, voffA);
        if (wr == 1) PG8_BAR;
        PG8_WAIT_V(2); PG8_BAR;
        PG8_STAGE(PG8_SB(1, 0), cB + kstep, voffB); PG8_STAGE(PG8_SA(1, 0), cA + kstep, voffA); PG8_STAGE(PG8_SB(1, 1), cB + hstep + kstep, voffB);
        PG8_WAIT_V(6); PG8_BAR;
    } else {
        PG8_STAGE(PG8_SB(0, 0), cB, voffB); PG8_STAGE(PG8_SA(0, 0), cA, voffA); PG8_STAGE(PG8_SB(0, 1), cB + hstep, voffB); PG8_STAGE(PG8_SA(0, 1), cA + hstep, voffA);
        if (wr == 1) PG8_BAR;
        PG8_WAIT_V(4); PG8_BAR;
        PG8_STAGE(PG8_SB(1, 0), cB + kstep, voffB); PG8_STAGE(PG8_SA(1, 0), cA + kstep, voffA); PG8_STAGE(PG8_SB(1, 1), cB + hstep + kstep, voffB);
        PG8_WAIT_V(6); PG8_BAR;
    }
    for (;;) {
        const bool has_next = S.next(ui + 1, nxt);
        const char* nA = has_next ? (const char*)g.A + (size_t)nxt.pm * tstep : cA; const char* nB = has_next ? (const char*)g.Bt + (size_t)nxt.pn * tstep : cB;
        for (int t = 0; t < nt; t += 2) {
            const bool last = (t == nt - 2);
            const char* a1 = cA + (size_t)(t + 1) * kstep;
            const char* a2 = last ? nA : cA + (size_t)(t + 2) * kstep; const char* b2 = last ? nB : cB + (size_t)(t + 2) * kstep;
            const char* a3 = a2 + kstep; const char* b3 = b2 + kstep;
            if (last && has_next) S.a_ready(nxt);
            if constexpr (SP2) {
            PG8_LDB(B0, 0, 0); PG8_LDB(B1, 0, 1); PG8_SCHED; PG8_LDA(At, 0, 0); PG8_STAGE(PG8_SA(1, 1), a1 + hstep, voffA);
            PG8_WAIT_V(8); PG8_WAIT_L(0); PG8_BAR; PG8_MMA(0, 0, At, B0); PG8_MMA(0, 1, At, B1); PG8_BAR; PG8_SCHED;
            PG8_LDA(At, 0, 1); PG8_STAGE(PG8_SB(0, 0), b2, voffB); PG8_STAGE(PG8_SB(0, 1), b2 + hstep, voffB); PG8_STAGE(PG8_SA(0, 0), a2, voffA);
            PG8_WAIT_V(8); PG8_WAIT_L(0); PG8_BAR; PG8_MMA(1, 0, At, B0); PG8_MMA(1, 1, At, B1); PG8_BAR; PG8_SCHED;
            PG8_LDB(B0, 1, 0); PG8_LDB(B1, 1, 1); PG8_SCHED; PG8_LDA(At, 1, 0); PG8_STAGE(PG8_SA(0, 1), a2 + hstep, voffA);
            PG8_WAIT_V(8); PG8_WAIT_L(0); PG8_BAR; PG8_MMA(0, 0, At, B0); PG8_MMA(0, 1, At, B1); PG8_BAR; PG8_SCHED;
            PG8_LDA(At, 1, 1); PG8_STAGE(PG8_SB(1, 0), b3, voffB); PG8_STAGE(PG8_SB(1, 1), b3 + hstep, voffB); PG8_STAGE(PG8_SA(1, 0), a3, voffA);
            PG8_WAIT_V(8); PG8_WAIT_L(0); PG8_BAR; PG8_MMA(1, 0, At, B0); PG8_MMA(1, 1, At, B1); PG8_BAR; PG8_SCHED;
            } else {
            PG8_LDB(B0, 0, 0); PG8_SCHED; PG8_LDA(At, 0, 0); PG8_STAGE(PG8_SA(1, 1), a1 + hstep, voffA);
            PG8_WAIT_L(8); PG8_BAR; PG8_WAIT_L(0); PG8_MMA(0, 0, At, B0); PG8_BAR; PG8_SCHED;
            PG8_LDB(B1, 0, 1); PG8_STAGE(PG8_SB(0, 0), b2, voffB);
            PG8_BAR; PG8_WAIT_L(0); PG8_MMA(0, 1, At, B1); PG8_BAR;
            PG8_LDA(At, 0, 1); PG8_STAGE(PG8_SA(0, 0), a2, voffA);
            PG8_BAR; PG8_WAIT_L(0); PG8_MMA(1, 0, At, B0); PG8_BAR; PG8_SCHED;
            PG8_STAGE(PG8_SB(0, 1), b2 + hstep, voffB);
            PG8_WAIT_V(6); PG8_BAR; PG8_MMA(1, 1, At, B1); PG8_BAR;
            PG8_LDB(B0, 1, 0); PG8_SCHED; PG8_LDA(At, 1, 0); PG8_STAGE(PG8_SA(0, 1), a2 + hstep, voffA);
            PG8_WAIT_L(8); PG8_BAR; PG8_WAIT_L(0); PG8_MMA(0, 0, At, B0); PG8_BAR; PG8_SCHED;
            PG8_LDB(B1, 1, 1); PG8_STAGE(PG8_SB(1, 0), b3, voffB);
            PG8_BAR; PG8_WAIT_L(0); PG8_MMA(0, 1, At, B1); PG8_BAR;
            PG8_LDA(At, 1, 1); PG8_STAGE(PG8_SA(1, 0), a3, voffA);
            PG8_BAR; PG8_WAIT_L(0); PG8_MMA(1, 0, At, B0); PG8_BAR; PG8_SCHED;
            PG8_STAGE(PG8_SB(1, 1), b3 + hstep, voffB);
            PG8_WAIT_V(6); PG8_BAR; PG8_MMA(1, 1, At, B1); PG8_BAR;
            }
        }
        if constexpr (ALIGN_EPI) { if (wr == 0) PG8_BAR; }
        if constexpr (!Epi::AFTER_DRAIN) { E(acc, cur, wr, wc, fr, fq); S.done(cur); }
        if (!has_next) break;
#pragma unroll
        for (int a = 0; a < 2; ++a)
#pragma unroll
            for (int b = 0; b < 2; ++b)
#pragma unroll
                for (int m = 0; m < 4; ++m)
#pragma unroll
                    for (int n = 0; n < 2; ++n) acc[a][b][m][n] = (f32x4){0.f, 0.f, 0.f, 0.f};
        cur = nxt; cA = nA; cB = nB; ++ui;
        if constexpr (ALIGN_EPI) { if (wr == 1) PG8_BAR; }
    }
    PG8_WAIT_V(0);
    if constexpr (!ALIGN_EPI) { if (wr == 0) PG8_BAR; }
    PG8_BAR;
    if constexpr (Epi::AFTER_DRAIN) { E.fused(acc, cur, wr, wc, fr, fq, lds, wid, lane); S.done(cur); }
#undef PG8_SA
#undef PG8_SB
#undef PG8_STAGE
#undef PG8_LDA
#undef PG8_LDB
#undef PG8_MMA
#undef PG8_WAIT_V
#undef PG8_WAIT_L
#undef PG8_BAR
#undef PG8_SCHED
}
}

#ifndef PG8_SP2
#define PG8_SP2 true
#endif
#ifndef PG8_ALIGN
#define PG8_ALIGN true
#endif
constexpr int NWAVES = 8;
constexpr int BATCH = 4, SEQ = 2048, D = 2048, DEPTH = 4, M = BATCH * SEQ;
constexpr int PLE = 256, SSD_INNER = 4096, HEADS = 64, HD = 64, GROUPS = 8, NSTATE = 128, XBC = 6144, DFF = 5632, DIN = 20544;
constexpr float EPS = 1e-6f;
constexpr int PC_Z = 0, PC_XBC = 4096, PC_SCB = 10240, PC_SCC = 12288, PC_SCX = 14336, PC_GA = 16384, PC_GB = 18432, PC_DT = 20480, NP = 20736;
constexpr size_t MiB = 1u << 20;
constexpr size_t WS_CTL = 0, CTL_ZERO_BYTES = 1 * MiB;
constexpr size_t WL_WIN = 0, WL_SSDOUT = 81 * MiB, WL_SCOUT = 97 * MiB, WL_WO = 105 * MiB, WL_WGU = 113 * MiB, WL_WDOWN = 157 * MiB, WL_PLEG = 179 * MiB, WL_PLEP = 187 * MiB, WL_STRIDE = 188 * MiB;
constexpr size_t WS_W = 1 * MiB;
constexpr size_t WS_XN = WS_W + 4 * WL_STRIDE;
constexpr size_t WS_PROJ = WS_XN + 32 * MiB;
constexpr size_t WS_ACT = WS_PROJ;
constexpr size_t WS_YG = WS_PROJ + 324 * MiB;
constexpr size_t WS_YSC = WS_YG + 64 * MiB;
constexpr size_t WS_T = WS_YSC + 32 * MiB;
constexpr size_t WS_MRG = WS_T + 64 * MiB;
constexpr size_t WS_H = WS_MRG + 32 * MiB;
constexpr size_t WS_E = WS_H + 64 * MiB;
constexpr size_t WS_PBF = WS_E + 32 * MiB;
constexpr size_t WS_END = WS_PBF + 16 * MiB;
constexpr int CW_BAR = 4096;
constexpr int LDS_BYTES = 147456;
constexpr int RING_OFF = 0;
constexpr int MISC_OFF = LDS_BYTES - 256;

#define GAS __attribute__((address_space(1)))
#define LAS __attribute__((address_space(3)))
typedef unsigned short bf16;
typedef unsigned v4u __attribute__((ext_vector_type(4)));
typedef unsigned v2u __attribute__((ext_vector_type(2)));
typedef float f32x4 __attribute__((ext_vector_type(4)));
#define LDS_WAIT() asm volatile("s_waitcnt lgkmcnt(0)" ::: "memory")
#define VM_WAIT() asm volatile("s_waitcnt vmcnt(0)" ::: "memory")
__device__ __forceinline__ unsigned f2bf(float f) { unsigned u = __builtin_bit_cast(unsigned, f); return (u + 0x7fffu + ((u >> 16) & 1u)) >> 16; }
__device__ __forceinline__ unsigned pk2(float lo, float hi) { return f2bf(lo) | (f2bf(hi) << 16); }
__device__ __forceinline__ float bf2f(bf16 b) { return __uint_as_float(((unsigned)b) << 16); }
__device__ __forceinline__ float blo(unsigned w) { return __uint_as_float(w << 16); }
__device__ __forceinline__ float bhi(unsigned w) { return __uint_as_float(w & 0xffff0000u); }
__device__ __forceinline__ float sigm(float x) { return 1.0f / (1.0f + __expf(-x)); }
__device__ __forceinline__ float silu(float x) { return x * sigm(x); }
__device__ __forceinline__ float softplus(float x) { return x > 20.f ? x : log1pf(__expf(x)); }

#define XB_TMO      128
#define XB_XCNT(j)  (256  + 64 * (j))
#define XB_XSUB(j)  (1280 + 64 * (j))
#define XB_XGEN(j)  (2304 + 64 * (j))
#define XB_TOP      3328
#define XB_TOPGEN   3392
#define XCD_BAR_WORDS 3456
#define XB_SPIN_CAP (1u << 18)

__device__ __forceinline__ unsigned xb_ld(unsigned* p)              { return __hip_atomic_load(p, __ATOMIC_RELAXED, __HIP_MEMORY_SCOPE_AGENT); }
__device__ __forceinline__ unsigned xb_add(unsigned* p, unsigned v) { return __hip_atomic_fetch_add(p, v, __ATOMIC_RELAXED, __HIP_MEMORY_SCOPE_AGENT); }
__device__ __forceinline__ unsigned xb_xcc_id() { return (unsigned)__builtin_amdgcn_s_getreg((3 << 11) | 20) & 0xFu; }
#define XB_SPIN(cond, bar) do { unsigned _sp = 0; while (cond) { __builtin_amdgcn_s_sleep(1); \
    if ((++_sp & 255u) == 0u) { if (xb_ld(&(bar)[XB_TMO])) break; if (_sp > XB_SPIN_CAP) { atomicAdd(&(bar)[XB_TMO], 1u); break; } } } } while (0)

struct XcdBarrier {
    unsigned* bar; unsigned x;
    volatile LAS unsigned* st;
};

__device__ __forceinline__ XcdBarrier xcd_barrier_post(unsigned* bar, volatile LAS unsigned* st) {
    XcdBarrier b; b.bar = bar; b.x = xb_xcc_id(); b.st = st;
    if (threadIdx.x == 0) (void)xb_add(&bar[XB_XCNT(b.x)], 1u);
    return b;
}
__device__ __forceinline__ void xcd_barrier_complete(unsigned* bar, unsigned x, unsigned& nloc, unsigned& nx) {
    const unsigned G = gridDim.x * gridDim.y * gridDim.z;
    unsigned sum, cnt, mine, sp = 0u;
    for (;;) {
        sum = 0u; cnt = 0u; mine = 0u;
#pragma unroll
        for (unsigned j = 0; j < 16; ++j) { const unsigned c = xb_ld(&bar[XB_XCNT(j)]); sum += c; cnt += (c > 0u) ? 1u : 0u; mine = (j == x) ? c : mine; }
        if (sum == G) break;
        __builtin_amdgcn_s_sleep(1);
        if ((++sp & 255u) == 0u) { if (xb_ld(&bar[XB_TMO])) break; if (sp > XB_SPIN_CAP) { atomicAdd(&bar[XB_TMO], 1u); break; } }
    }
    nloc = mine > 0u ? mine : 1u; nx = cnt > 0u ? cnt : 1u;
}

__device__ __forceinline__ void xcd_barrier(const XcdBarrier& b) {
    asm volatile("s_waitcnt vmcnt(0)" ::: "memory");
    __syncthreads();
    if (threadIdx.x == 0) {
        int zofs = 0; asm volatile("" : "+s"(zofs)); unsigned* bar = b.bar + zofs;
        __builtin_amdgcn_s_waitcnt(0);
        unsigned nloc = b.st[0], nx = b.st[1];
        if (nloc == 0u) { xcd_barrier_complete(bar, b.x, nloc, nx); b.st[0] = nloc; b.st[1] = nx; }
        const unsigned old = xb_add(&bar[XB_XSUB(b.x)], 1u);
        const unsigned gen = old / nloc;
        if (old + 1u == (gen + 1u) * nloc) {
            __builtin_amdgcn_fence(__ATOMIC_RELEASE, "agent");
            asm volatile("s_waitcnt vmcnt(0)" ::: "memory");
            const unsigned og = xb_add(&bar[XB_TOP], 1u);
            const unsigned tg = og / nx;
            if (og + 1u == (tg + 1u) * nx) xb_add(&bar[XB_TOPGEN], 1u);
            else XB_SPIN(xb_ld(&bar[XB_TOPGEN]) == tg, bar);
            __builtin_amdgcn_fence(__ATOMIC_ACQUIRE, "agent");
            xb_add(&bar[XB_XGEN(b.x)], 1u);
            asm volatile("s_waitcnt vmcnt(0)" ::: "memory");
        } else {
            XB_SPIN(xb_ld(&bar[XB_XGEN(b.x)]) == gen, bar);
            __builtin_amdgcn_fence(__ATOMIC_ACQUIRE, "agent");
            asm volatile("s_waitcnt vmcnt(0)" ::: "memory");
        }
    }
    __syncthreads();
}
struct Params {
    const float *x, *p, *norm_mix, *w_in, *ssd_conv_w, *ssd_conv_b, *ssd_dt_bias, *ssd_a_log, *ssd_d, *ssd_norm, *ssd_out, *sc_conv_w, *sc_out, *w_o, *norm_ffn, *w_gate_up, *w_down, *norm_ple, *ple_gate, *ple_proj, *norm_final;
    float* out; unsigned char* ws;
};
static_assert(sizeof(Params) == 23 * 8, "Params has no padding");

__device__ __forceinline__ float wave_sum(float v) {
#pragma unroll
    for (int o = 1; o < 64; o <<= 1) v += __shfl_xor(v, o);
    return v;
}
__device__ __forceinline__ int rowmap(int mode, int n) {
    if (mode == 1) return n < 10240 ? n : (n < 10304 ? n + (PC_DT - 10240) : n - 64);
    if (mode == 2) { const int isup = n >= DFF ? 1 : 0; const int f = n - isup * DFF;
        return 256 * (f >> 7) + 128 * ((f >> 6) & 1) + 32 * ((f >> 4) & 3) + 16 * isup + (f & 15); }
    return n;
}
__device__ __forceinline__ void transpose_item(const float* W, int K, int N, bf16* WT, int mode, LAS float* scr, int item, int lane) {
    const int nblk = N / 32, kb = item / nblk, nb = item % nblk, k0 = 64 * kb, n0 = 32 * nb;
#pragma unroll 8
    for (int i = 0; i < 32; ++i) { const int kk = 2 * i + (lane >> 5); scr[kk * 33 + (lane & 31)] = W[(size_t)(k0 + kk) * N + n0 + (lane & 31)]; }
    LDS_WAIT(); asm volatile("" ::: "memory");
    const int c = lane & 7;
#pragma unroll
    for (int j = 0; j < 4; ++j) { const int n = (lane >> 3) + 8 * j; const LAS float* s = scr + (8 * c) * 33 + n;
        v4u o; o.x = pk2(s[0 * 33], s[1 * 33]); o.y = pk2(s[2 * 33], s[3 * 33]); o.z = pk2(s[4 * 33], s[5 * 33]); o.w = pk2(s[6 * 33], s[7 * 33]);
        *(v4u*)(WT + (size_t)rowmap(mode, n0 + n) * K + k0 + 8 * c) = o; }
    LDS_WAIT(); asm volatile("" ::: "memory");
}
constexpr int I_WIN = (D / 64) * (DIN / 32), I_SSDOUT = (SSD_INNER / 64) * (D / 32), I_SQ = (D / 64) * (D / 32), I_WGU = (D / 64) * (2 * DFF / 32), I_WDOWN = (DFF / 64) * (D / 32), I_PLEP = (PLE / 64) * (D / 32);
constexpr int I_LAYER = I_WIN + I_SSDOUT + 3 * I_SQ + I_WGU + I_WDOWN + I_PLEP;

__device__ __forceinline__ void prologue(const Params& P, LAS unsigned char* L, int gw, int NGW, int wave, int lane) {
    LAS float* scr = (LAS float*)(L + RING_OFF + wave * 16384);
    unsigned char* ws = P.ws;
#ifndef DBG_SKIP_TRANSPOSE
    for (int it = gw; it < DEPTH * I_LAYER; it += NGW) {
        const int layer = it / I_LAYER; int r = it - layer * I_LAYER;
        unsigned char* wl = ws + WS_W + (size_t)layer * WL_STRIDE;
        if (r < I_WIN) { transpose_item(P.w_in + (size_t)layer * D * DIN, D, DIN, (bf16*)(wl + WL_WIN), 1, scr, r, lane); continue; } r -= I_WIN;
        if (r < I_SSDOUT) { transpose_item(P.ssd_out + (size_t)layer * SSD_INNER * D, SSD_INNER, D, (bf16*)(wl + WL_SSDOUT), 0, scr, r, lane); continue; } r -= I_SSDOUT;
        if (r < I_SQ) { transpose_item(P.sc_out + (size_t)layer * D * D, D, D, (bf16*)(wl + WL_SCOUT), 0, scr, r, lane); continue; } r -= I_SQ;
        if (r < I_SQ) { transpose_item(P.w_o + (size_t)layer * D * D, D, D, (bf16*)(wl + WL_WO), 0, scr, r, lane); continue; } r -= I_SQ;
        if (r < I_WGU) { transpose_item(P.w_gate_up + (size_t)layer * D * 2 * DFF, D, 2 * DFF, (bf16*)(wl + WL_WGU), 2, scr, r, lane); continue; } r -= I_WGU;
        if (r < I_WDOWN) { transpose_item(P.w_down + (size_t)layer * DFF * D, DFF, D, (bf16*)(wl + WL_WDOWN), 0, scr, r, lane); continue; } r -= I_WDOWN;
        if (r < I_SQ) { transpose_item(P.ple_gate + (size_t)layer * D * D, D, D, (bf16*)(wl + WL_PLEG), 0, scr, r, lane); continue; } r -= I_SQ;
        transpose_item(P.ple_proj + (size_t)layer * PLE * D, PLE, D, (bf16*)(wl + WL_PLEP), 0, scr, r, lane);
    }
#endif
#ifndef DBG_SKIP_PADP
    { constexpr int PADV = (NP - DIN) * D * 2 / 16;
      const int gt = gw * 64 + lane, NT = NGW * 64;
      for (int i = gt; i < DEPTH * PADV; i += NT) { const int layer = i / PADV, j = i - layer * PADV;
          *((v4u*)(ws + WS_W + (size_t)layer * WL_STRIDE + WL_WIN + (size_t)DIN * D * 2) + j) = (v4u){0u, 0u, 0u, 0u}; }
      const f32x4* ps = (const f32x4*)P.p; v2u* pd = (v2u*)(ws + WS_PBF);
      for (int i = gt; i < DEPTH * M * PLE / 4; i += NT) { const f32x4 v = ps[i]; v2u o; o.x = pk2(v[0], v[1]); o.y = pk2(v[2], v[3]); pd[i] = o; }
    }
#endif
}
__device__ __forceinline__ void rmsnorm_row_bf16(const float* xrow, const float* g, bf16* orow, int lane) {
    const f32x4* xr = (const f32x4*)xrow + lane; f32x4 v[8]; float s = 0.f;
#pragma unroll
    for (int j = 0; j < 8; ++j) { v[j] = xr[64 * j]; s += (v[j][0] * v[j][0] + v[j][1] * v[j][1]) + (v[j][2] * v[j][2] + v[j][3] * v[j][3]); }
    const float rs = 1.0f / sqrtf(wave_sum(s) * (1.0f / D) + EPS);
    const f32x4* gr = (const f32x4*)g + lane; v2u* o8 = (v2u*)orow + lane;
#pragma unroll
    for (int j = 0; j < 8; ++j) { const f32x4 gv = gr[64 * j]; v2u o; o.x = pk2(v[j][0] * rs * gv[0], v[j][1] * rs * gv[1]); o.y = pk2(v[j][2] * rs * gv[2], v[j][3] * rs * gv[3]); o8[64 * j] = o; }
}
__device__ __forceinline__ void rmsnorm_row_f32(const float* xrow, const float* g, float* orow, int lane) {
    const f32x4* xr = (const f32x4*)xrow + lane; f32x4 v[8]; float s = 0.f;
#pragma unroll
    for (int j = 0; j < 8; ++j) { v[j] = xr[64 * j]; s += (v[j][0] * v[j][0] + v[j][1] * v[j][1]) + (v[j][2] * v[j][2] + v[j][3] * v[j][3]); }
    const float rs = 1.0f / sqrtf(wave_sum(s) * (1.0f / D) + EPS);
    const f32x4* gr = (const f32x4*)g + lane; f32x4* o = (f32x4*)orow + lane;
#pragma unroll
    for (int j = 0; j < 8; ++j) { const f32x4 gv = gr[64 * j]; o[64 * j] = v[j] * rs * gv; }
}

__device__ __forceinline__ void ssd_naive_phase(const Params& P, LAS unsigned char* L, int layer, int tid) {
    const bf16* proj = (const bf16*)(P.ws + WS_PROJ); bf16* yg = (bf16*)(P.ws + WS_YG);
    const float* cw = P.ssd_conv_w + (size_t)layer * 4 * XBC; const float* cb = P.ssd_conv_b + (size_t)layer * XBC;
    LAS float* XS = (LAS float*)(L + RING_OFF);
    LAS float* DT = XS + 64 * 320;
    for (int unit = blockIdx.x; unit < BATCH * HEADS; unit += gridDim.x) {
        const int b = unit >> 6, h = unit & 63, g = h >> 3;
        const float a = -__expf(P.ssd_a_log[layer * HEADS + h]), dtb = P.ssd_dt_bias[layer * HEADS + h], dsk = P.ssd_d[layer * HEADS + h];
        const int p = tid >> 3, n0 = (tid & 7) * 16;
        float s[16];
#pragma unroll
        for (int j = 0; j < 16; ++j) s[j] = 0.f;
        for (int t0 = 0; t0 < SEQ; t0 += 64) {
            __syncthreads();
            for (int e = tid; e < 64 * 320; e += NWAVES * 64) {
                const int tl = e / 320, cc = e - tl * 320;
                const int ch = cc < 64 ? h * 64 + cc : (cc < 192 ? SSD_INNER + g * 128 + (cc - 64) : SSD_INNER + GROUPS * NSTATE + g * 128 + (cc - 192));
                const int t = t0 + tl; float v = cb[ch];
#pragma unroll
                for (int k = 0; k < 4; ++k) { const int tt = t - 3 + k; if (tt >= 0) v += cw[k * XBC + ch] * bf2f(proj[(size_t)(b * SEQ + tt) * NP + PC_XBC + ch]); }
                XS[tl * 320 + cc] = silu(v);
            }
            if (tid < 64) DT[tid] = softplus(bf2f(proj[(size_t)(b * SEQ + t0 + tid) * NP + PC_DT + h]) + dtb);
            __syncthreads();
            for (int tl = 0; tl < 64; ++tl) {
                const float dt = DT[tl], dA = __expf(a * dt), xp = XS[tl * 320 + p], dtx = dt * xp;
                float yp = 0.f;
#pragma unroll
                for (int j = 0; j < 16; ++j) { s[j] = s[j] * dA + dtx * XS[tl * 320 + 64 + n0 + j]; yp += s[j] * XS[tl * 320 + 192 + n0 + j]; }
                yp += __shfl_xor(yp, 1); yp += __shfl_xor(yp, 2); yp += __shfl_xor(yp, 4);
                if ((tid & 7) == 0) { const size_t row = (size_t)(b * SEQ + t0 + tl);
                    const float y = (yp + dsk * xp) * silu(bf2f(proj[row * NP + PC_Z + h * 64 + p]));
                    yg[row * SSD_INNER + h * 64 + p] = (bf16)f2bf(y); }
            }
        }
    }
}
__device__ __forceinline__ void n2_phase(const Params& P, int layer, int gw, int NGW, int lane) {
    const bf16* proj = (const bf16*)(P.ws + WS_PROJ); bf16* yg = (bf16*)(P.ws + WS_YG); bf16* ysc = (bf16*)(P.ws + WS_YSC);
    const float* nw = P.ssd_norm + (size_t)layer * SSD_INNER; const float* scw = P.sc_conv_w + (size_t)layer * 3 * D;
    for (int row = gw; row < M; row += NGW) {
#pragma unroll 2
        for (int g = 0; g < GROUPS; ++g) {
            v4u* ptr = (v4u*)(yg + (size_t)row * SSD_INNER + g * 512 + lane * 8); const v4u w = *ptr;
            float v[8] = {blo(w.x), bhi(w.x), blo(w.y), bhi(w.y), blo(w.z), bhi(w.z), blo(w.w), bhi(w.w)};
            float ss = 0.f;
#pragma unroll
            for (int j = 0; j < 8; ++j) ss += v[j] * v[j];
            const float rs = 1.0f / sqrtf(wave_sum(ss) * (1.0f / 512.0f) + EPS);
            const f32x4 n0 = *(const f32x4*)(nw + g * 512 + lane * 8), n1 = *(const f32x4*)(nw + g * 512 + lane * 8 + 4);
            v4u o; o.x = pk2(v[0] * rs * n0[0], v[1] * rs * n0[1]); o.y = pk2(v[2] * rs * n0[2], v[3] * rs * n0[3]); o.z = pk2(v[4] * rs * n1[0], v[5] * rs * n1[1]); o.w = pk2(v[6] * rs * n1[2], v[7] * rs * n1[3]);
            *ptr = o;
        }
        const int t = row % SEQ;
#pragma unroll 1
        for (int q = 0; q < 4; ++q) {
            const int c = q * 512 + lane * 8; float acc[8];
#pragma unroll
            for (int j = 0; j < 8; ++j) acc[j] = 0.f;
#pragma unroll
            for (int k = 0; k < 3; ++k) { const int tt = t - 2 + k;
                if (tt >= 0) { const size_t r2 = (size_t)(row - 2 + k);
                    const v4u bw = *(const v4u*)(proj + r2 * NP + PC_SCB + c), xw = *(const v4u*)(proj + r2 * NP + PC_SCX + c);
                    const f32x4 w0 = *(const f32x4*)(scw + k * D + c), w1 = *(const f32x4*)(scw + k * D + c + 4);
                    acc[0] += w0[0] * (blo(bw.x) * blo(xw.x)); acc[1] += w0[1] * (bhi(bw.x) * bhi(xw.x)); acc[2] += w0[2] * (blo(bw.y) * blo(xw.y)); acc[3] += w0[3] * (bhi(bw.y) * bhi(xw.y));
                    acc[4] += w1[0] * (blo(bw.z) * blo(xw.z)); acc[5] += w1[1] * (bhi(bw.z) * bhi(xw.z)); acc[6] += w1[2] * (blo(bw.w) * blo(xw.w)); acc[7] += w1[3] * (bhi(bw.w) * bhi(xw.w)); } }
            const v4u cv = *(const v4u*)(proj + (size_t)row * NP + PC_SCC + c);
            v4u o; o.x = pk2(blo(cv.x) * acc[0], bhi(cv.x) * acc[1]); o.y = pk2(blo(cv.y) * acc[2], bhi(cv.y) * acc[3]); o.z = pk2(blo(cv.z) * acc[4], bhi(cv.z) * acc[5]); o.w = pk2(blo(cv.w) * acc[6], bhi(cv.w) * acc[7]);
            *(v4u*)(ysc + (size_t)row * D + c) = o;
        }
    }
}

#ifndef DBG_STOP_AT
#define DBG_STOP_AT -1
#endif
#define DBG_STOP(k) do { if (DBG_STOP_AT == (k)) return; } while (0)
__device__ __forceinline__ int fresh_tid(int wave_s) { int l = __builtin_amdgcn_mbcnt_hi(~0u, __builtin_amdgcn_mbcnt_lo(~0u, 0u)); asm volatile("" : "+v"(l)); return wave_s * 64 + l; }
__global__ void __launch_bounds__(NWAVES * 64, 2) trunk_fwd(Params P) {
    extern __shared__ __attribute__((aligned(16))) unsigned char lds[];
    LAS unsigned char* L = (LAS unsigned char*)lds;
    DBG_STOP(-2);
    volatile LAS unsigned* MISC = (volatile LAS unsigned*)(L + MISC_OFF);
    const int tid0 = threadIdx.x, lane0 = tid0 & 63, wave0 = __builtin_amdgcn_readfirstlane(tid0 >> 6);
    const int G = gridDim.x; const int bx = blockIdx.x; const int vcu = (G % 8 == 0) ? (bx % 8) * (G / 8) + bx / 8 : bx;
    const int gw0 = vcu * NWAVES + wave0, NGW = G * NWAVES;
    if (tid0 < 64) MISC[tid0] = 0u;
    __syncthreads();
    unsigned char* ws = P.ws;
    XcdBarrier bar = xcd_barrier_post((unsigned*)(ws + WS_CTL) + CW_BAR, MISC + 8);

    bf16* XN = (bf16*)(ws + WS_XN); bf16* PROJ = (bf16*)(ws + WS_PROJ); bf16* ACT = (bf16*)(ws + WS_ACT); bf16* YG = (bf16*)(ws + WS_YG); bf16* YSC = (bf16*)(ws + WS_YSC);
    float* T = (float*)(ws + WS_T); bf16* MRG = (bf16*)(ws + WS_MRG); float* H = (float*)(ws + WS_H); bf16* EB = (bf16*)(ws + WS_E); bf16* PBF = (bf16*)(ws + WS_PBF);

    prologue(P, L, gw0, NGW, wave0, lane0);
    xcd_barrier(bar);
    DBG_STOP(0);

    for (int layer = 0; layer < DEPTH; ++layer) {
        int lane = __builtin_amdgcn_mbcnt_hi(~0u, __builtin_amdgcn_mbcnt_lo(~0u, 0u)); asm volatile("" : "+v"(lane));
        const int wave = wave0, tid = wave * 64 + lane, gw = vcu * NWAVES + wave;
        unsigned char* wl = ws + WS_W + (size_t)layer * WL_STRIDE;
        const float* hin = layer == 0 ? P.x : (const float*)H;
        for (int row = gw; row < M; row += NGW) rmsnorm_row_bf16(hin + (size_t)row * D, P.norm_mix + (size_t)layer * D, XN + (size_t)row * D, lane);
        xcd_barrier(bar);
        DBG_STOP(1);
        { pg8::Gemm g{XN, (const bf16*)(wl + WL_WIN), M, NP, D}; pg8::StaticOrder S; S.init(M, NP, G, bx);
          pg8::EpiStoreBf16 E{PROJ, NP};
          pg8::gemm_phase<pg8::EpiStoreBf16, pg8::StaticOrder, PG8_ALIGN, PG8_SP2>(L + RING_OFF, g, S, E, fresh_tid(wave0)); }
        xcd_barrier(bar);
        DBG_STOP(2);
        ssd_naive_phase(P, L, layer, fresh_tid(wave0));
        xcd_barrier(bar);
        DBG_STOP(3);
        n2_phase(P, layer, gw, NGW, lane);
        xcd_barrier(bar);
        DBG_STOP(4);
        { pg8::Gemm g{YG, (const bf16*)(wl + WL_SSDOUT), M, D, SSD_INNER}; pg8::StaticOrder S; S.init(M, D, G, bx);
          pg8::EpiGateMulF32 E{T, D, PROJ + PC_GA, NP};
          pg8::gemm_phase<pg8::EpiGateMulF32, pg8::StaticOrder, PG8_ALIGN, PG8_SP2>(L + RING_OFF, g, S, E, fresh_tid(wave0)); }
        __syncthreads();
        { pg8::Gemm g{YSC, (const bf16*)(wl + WL_SCOUT), M, D, D}; pg8::StaticOrder S; S.init(M, D, G, bx);
          pg8::EpiGateAddBf16 E{T, D, PROJ + PC_GB, NP, MRG, D};
          pg8::gemm_phase<pg8::EpiGateAddBf16, pg8::StaticOrder, PG8_ALIGN, PG8_SP2>(L + RING_OFF, g, S, E, fresh_tid(wave0)); }
        xcd_barrier(bar);
        DBG_STOP(5);
        { pg8::Gemm g{MRG, (const bf16*)(wl + WL_WO), M, D, D}; pg8::StaticOrder S; S.init(M, D, G, bx);
          pg8::EpiResidF32 E{hin, H, D};
          pg8::gemm_phase<pg8::EpiResidF32, pg8::StaticOrder, PG8_ALIGN, PG8_SP2>(L + RING_OFF, g, S, E, fresh_tid(wave0)); }
        xcd_barrier(bar);
        DBG_STOP(6);
        for (int row = gw; row < M; row += NGW) rmsnorm_row_bf16(H + (size_t)row * D, P.norm_ffn + (size_t)layer * D, XN + (size_t)row * D, lane);
        xcd_barrier(bar);
        DBG_STOP(7);
        { pg8::Gemm g{XN, (const bf16*)(wl + WL_WGU), M, 2 * DFF, D}; pg8::StaticOrder S; S.init(M, 2 * DFF, G, bx);
          pg8::EpiSwiGLU E{ACT, DFF};
          pg8::gemm_phase<pg8::EpiSwiGLU, pg8::StaticOrder, PG8_ALIGN, PG8_SP2>(L + RING_OFF, g, S, E, fresh_tid(wave0)); }
        xcd_barrier(bar);
        DBG_STOP(8);
        { pg8::Gemm g{ACT, (const bf16*)(wl + WL_WDOWN), M, D, DFF}; pg8::StaticOrder S; S.init(M, D, G, bx);
          pg8::EpiResidF32 E{H, H, D};
          pg8::gemm_phase<pg8::EpiResidF32, pg8::StaticOrder, PG8_ALIGN, PG8_SP2>(L + RING_OFF, g, S, E, fresh_tid(wave0)); }
        xcd_barrier(bar);
        DBG_STOP(9);
        for (int row = gw; row < M; row += NGW) rmsnorm_row_bf16(H + (size_t)row * D, P.norm_ple + (size_t)layer * D, XN + (size_t)row * D, lane);
        xcd_barrier(bar);
        DBG_STOP(10);
        { pg8::Gemm g{PBF + (size_t)layer * M * PLE, (const bf16*)(wl + WL_PLEP), M, D, PLE}; pg8::StaticOrder S; S.init(M, D, G, bx);
          pg8::EpiStoreBf16 E{EB, D};
          pg8::gemm_phase<pg8::EpiStoreBf16, pg8::StaticOrder, PG8_ALIGN, PG8_SP2>(L + RING_OFF, g, S, E, fresh_tid(wave0)); }
        __syncthreads();
        { pg8::Gemm g{XN, (const bf16*)(wl + WL_PLEG), M, D, D}; pg8::StaticOrder S; S.init(M, D, G, bx);
          pg8::EpiPle E{H, EB, D};
          pg8::gemm_phase<pg8::EpiPle, pg8::StaticOrder, PG8_ALIGN, PG8_SP2>(L + RING_OFF, g, S, E, fresh_tid(wave0)); }
        xcd_barrier(bar);
    }
    { const int lane = __builtin_amdgcn_mbcnt_hi(~0u, __builtin_amdgcn_mbcnt_lo(~0u, 0u));
      for (int row = gw0; row < M; row += NGW) rmsnorm_row_f32(H + (size_t)row * D, P.norm_final, P.out + (size_t)row * D, lane); }
}

extern "C" void kernel_launch(void* const* d_in, const int* in_sizes, int n_in, void* d_out, int out_size, void* d_ws, size_t ws_size, hipStream_t stream) {
    static int grid = 0;
    if (grid == 0) {
        if (n_in != 21 || in_sizes[0] != M * D || out_size != M * D || ws_size < WS_END) { fprintf(stderr, "kernel_launch: unexpected shapes (n_in %d, in0 %d, out %d, ws %zu; need ws >= %zu); nothing launched\n", n_in, n_in > 0 ? in_sizes[0] : -1, out_size, ws_size, (size_t)WS_END); grid = -1; return; }
        int dev = 0, cus = 0, per_cu = 0;
        if (hipGetDevice(&dev) != hipSuccess || hipDeviceGetAttribute(&cus, hipDeviceAttributeMultiprocessorCount, dev) != hipSuccess) { fprintf(stderr, "kernel_launch: device query failed\n"); grid = -1; return; }
        if (hipFuncSetAttribute((const void*)trunk_fwd, hipFuncAttributeMaxDynamicSharedMemorySize, LDS_BYTES) != hipSuccess) { fprintf(stderr, "kernel_launch: hipFuncSetAttribute failed\n"); grid = -1; return; }
        if (hipOccupancyMaxActiveBlocksPerMultiprocessor(&per_cu, (const void*)trunk_fwd, NWAVES * 64, LDS_BYTES) != hipSuccess || per_cu < 1)
            fprintf(stderr, "kernel_launch: note: occupancy query reports %d workgroups per CU\n", per_cu);
        (void)hipGetLastError();
        grid = cus;
    }
    if (grid < 0) return;
    if (hipMemsetAsync((char*)d_ws + WS_CTL, 0, CTL_ZERO_BYTES, stream) != hipSuccess) { fprintf(stderr, "kernel_launch: memset failed\n"); return; }
    Params a{};
    a.x = (const float*)d_in[0]; a.p = (const float*)d_in[1]; a.norm_mix = (const float*)d_in[2]; a.w_in = (const float*)d_in[3]; a.ssd_conv_w = (const float*)d_in[4]; a.ssd_conv_b = (const float*)d_in[5];
    a.ssd_dt_bias = (const float*)d_in[6]; a.ssd_a_log = (const float*)d_in[7]; a.ssd_d = (const float*)d_in[8]; a.ssd_norm = (const float*)d_in[9]; a.ssd_out = (const float*)d_in[10]; a.sc_conv_w = (const float*)d_in[11];
    a.sc_out = (const float*)d_in[12]; a.w_o = (const float*)d_in[13]; a.norm_ffn = (const float*)d_in[14]; a.w_gate_up = (const float*)d_in[15]; a.w_down = (const float*)d_in[16]; a.norm_ple = (const float*)d_in[17];
    a.ple_gate = (const float*)d_in[18]; a.ple_proj = (const float*)d_in[19]; a.norm_final = (const float*)d_in[20];
    a.out = (float*)d_out; a.ws = (unsigned char*)d_ws;
    hipLaunchKernelGGL(trunk_fwd, dim3(grid), dim3(NWAVES * 64), LDS_BYTES, stream, a);
    const hipError_t le = hipPeekAtLastError();
    if (le != hipSuccess) fprintf(stderr, "kernel_launch: launch failed: %s\n", hipGetErrorName(le));
}
```

```cpp
#include <hip/hip_runtime.h>
#include <cstdio>
#include <cstdint>
namespace pg8 {
#define PG8_LAS __attribute__((address_space(3)))
typedef unsigned short bf16_t;
typedef short bf16x8 __attribute__((ext_vector_type(8)));
typedef float f32x4 __attribute__((ext_vector_type(4)));
typedef unsigned u32x4 __attribute__((ext_vector_type(4)));
constexpr int BM = 256, BK = 64, HALF = 128, HTB = HALF * BK * 2  , STAGE_BYTES = 8 * HTB, NXCD = 8, WGM = 8;

__host__ __device__ __forceinline__ int lds_byte(int r, int c) { const int st = (r >> 4) * 2 + (c >> 5), rr = r & 15, cc = c & 31, ob = rr * 64 + cc * 2; return st * 1024 + (ob ^ (((ob >> 9) & 1) << 5)); }
__host__ __device__ __forceinline__ void stage_rc(int b, int& R, int& C) { const int st = b / 1024, sb = b % 1024, swz = sb ^ (((sb >> 9) & 1) << 5); R = (st >> 1) * 16 + swz / 64; C = (st & 1) * 32 + (swz % 64) / 2; }
__host__ __device__ __forceinline__ int perm32(int rho) { const int n = rho >> 4, i = rho & 15; return 8 * (i >> 2) + 4 * n + (i & 3); }

struct Unit { int pm, pn; };
struct Gemm { const bf16_t* A; const bf16_t* Bt; int M, N, K; };

struct StaticOrder {
    int nM, nN, nwg, G, c;
    __host__ __device__ void init(int M, int N, int G_, int c_) { nM = M / BM; nN = N / BM; nwg = nM * nN; G = G_; c = c_; }
    __host__ __device__ bool next(int i, Unit& u) const {
        const long L = (long)i * G + c; if (L >= nwg) return false;
        int wgid = (int)L; { const int q = nwg / NXCD, r = nwg % NXCD, xcd = wgid % NXCD, off = wgid / NXCD; wgid = (xcd < r ? xcd * (q + 1) : r * (q + 1) + (xcd - r) * q) + off; }
        const int nig = WGM * nN, gid = wgid / nig, fm = gid * WGM, gsz = (nM - fm) < WGM ? (nM - fm) : WGM;
        u.pm = fm + ((wgid % nig) % gsz); u.pn = (wgid % nig) / gsz; return true;
    }
    __device__ __forceinline__ void a_ready(const Unit&) const {}
    __device__ __forceinline__ void done(const Unit&) const {}
};

typedef __bf16 bf16x2_t __attribute__((ext_vector_type(2)));
typedef float f32x2_t __attribute__((ext_vector_type(2)));
__device__ __forceinline__ unsigned cvt_pk_bf16(float lo, float hi) { const f32x2_t v = {lo, hi}; const bf16x2_t c = __builtin_convertvector(v, bf16x2_t); return __builtin_bit_cast(unsigned, c); }
typedef unsigned u32x2 __attribute__((ext_vector_type(2)));
__device__ __forceinline__ float bf_lo(unsigned w) { return __uint_as_float(w << 16); }
__device__ __forceinline__ float bf_hi(unsigned w) { return __uint_as_float(w & 0xffff0000u); }
__device__ __forceinline__ float sigmoidf_fast(float x) { return __builtin_amdgcn_rcpf(1.0f + __expf(-x)); }
__device__ __forceinline__ float siluf_fast(float x) { return x * sigmoidf_fast(x); }

struct EpiStoreBf16 {
    static constexpr bool PERM = true, AFTER_DRAIN = false;
    bf16_t* O; int ldc;
    __device__ __forceinline__ void operator()(const f32x4 (&acc)[2][2][4][2], const Unit& u, int wr, int wc, int fr, int fq) const {
        const int row0 = u.pm * BM + wr * 64 + fr, col0 = u.pn * BM + wc * 32 + 8 * fq;
#pragma unroll
        for (int ai = 0; ai < 2; ++ai)
#pragma unroll
            for (int m = 0; m < 4; ++m) { bf16_t* rowp = O + (size_t)(row0 + ai * HALF + m * 16) * ldc + col0;
#pragma unroll
                for (int bj = 0; bj < 2; ++bj) { const f32x4 v0 = acc[ai][bj][m][0], v1 = acc[ai][bj][m][1];
                    u32x4 w; w.x = cvt_pk_bf16(v0[0], v0[1]); w.y = cvt_pk_bf16(v0[2], v0[3]); w.z = cvt_pk_bf16(v1[0], v1[1]); w.w = cvt_pk_bf16(v1[2], v1[3]);
                    *(u32x4*)(rowp + bj * HALF) = w; } }
    }
};
struct EpiGateMulF32 {
    static constexpr bool PERM = false, AFTER_DRAIN = false;
    float* T; int ldt; const bf16_t* G; int ldg;
    __device__ __forceinline__ void operator()(const f32x4 (&acc)[2][2][4][2], const Unit& u, int wr, int wc, int fr, int fq) const {
        const int row0 = u.pm * BM + wr * 64 + fr, col0 = u.pn * BM + wc * 32 + 4 * fq;
#pragma unroll
        for (int ai = 0; ai < 2; ++ai)
#pragma unroll
            for (int m = 0; m < 4; ++m) { const size_t r = (size_t)(row0 + ai * HALF + m * 16);
#pragma unroll
                for (int bj = 0; bj < 2; ++bj)
#pragma unroll
                    for (int n = 0; n < 2; ++n) { const int c = col0 + bj * HALF + n * 16;
                        const u32x2 gw = *(const u32x2*)(G + r * ldg + c); const f32x4 a = acc[ai][bj][m][n];
                        f32x4 o; o[0] = sigmoidf_fast(bf_lo(gw.x)) * a[0]; o[1] = sigmoidf_fast(bf_hi(gw.x)) * a[1]; o[2] = sigmoidf_fast(bf_lo(gw.y)) * a[2]; o[3] = sigmoidf_fast(bf_hi(gw.y)) * a[3];
                        *(f32x4*)(T + r * ldt + c) = o; }
                asm volatile("" ::: "memory"); }
    }
};
struct EpiGateAddBf16 {
    static constexpr bool PERM = false, AFTER_DRAIN = false;
    const float* T; int ldt; const bf16_t* G; int ldg; bf16_t* O; int ldo;
    __device__ __forceinline__ void operator()(const f32x4 (&acc)[2][2][4][2], const Unit& u, int wr, int wc, int fr, int fq) const {
        const int row0 = u.pm * BM + wr * 64 + fr, col0 = u.pn * BM + wc * 32 + 4 * fq;
#pragma unroll
        for (int ai = 0; ai < 2; ++ai)
#pragma unroll
            for (int m = 0; m < 4; ++m) { const size_t r = (size_t)(row0 + ai * HALF + m * 16);
#pragma unroll
                for (int bj = 0; bj < 2; ++bj)
#pragma unroll
                    for (int n = 0; n < 2; ++n) { const int c = col0 + bj * HALF + n * 16;
                        const u32x2 gw = *(const u32x2*)(G + r * ldg + c); const f32x4 t = *(const f32x4*)(T + r * ldt + c); const f32x4 a = acc[ai][bj][m][n];
                        const float o0 = t[0] + sigmoidf_fast(bf_lo(gw.x)) * a[0], o1 = t[1] + sigmoidf_fast(bf_hi(gw.x)) * a[1], o2 = t[2] + sigmoidf_fast(bf_lo(gw.y)) * a[2], o3 = t[3] + sigmoidf_fast(bf_hi(gw.y)) * a[3];
                        u32x2 w; w.x = cvt_pk_bf16(o0, o1); w.y = cvt_pk_bf16(o2, o3);
                        *(u32x2*)(O + r * ldo + c) = w; }
                asm volatile("" ::: "memory"); }
    }
};
struct EpiResidF32 {
    static constexpr bool PERM = false, AFTER_DRAIN = false;
    const float* Hin; float* Hout; int ld;
    __device__ __forceinline__ void operator()(const f32x4 (&acc)[2][2][4][2], const Unit& u, int wr, int wc, int fr, int fq) const {
        const int row0 = u.pm * BM + wr * 64 + fr, col0 = u.pn * BM + wc * 32 + 4 * fq;
#pragma unroll
        for (int ai = 0; ai < 2; ++ai)
#pragma unroll
            for (int m = 0; m < 4; ++m) { const size_t off = (size_t)(row0 + ai * HALF + m * 16) * ld + col0;
#pragma unroll
                for (int bj = 0; bj < 2; ++bj)
#pragma unroll
                    for (int n = 0; n < 2; ++n) { const f32x4 hv = *(const f32x4*)(Hin + off + bj * HALF + n * 16);
                        *(f32x4*)(Hout + off + bj * HALF + n * 16) = hv + acc[ai][bj][m][n]; }
                asm volatile("" ::: "memory"); }
    }
};
struct EpiSwiGLU {
    static constexpr bool PERM = false, AFTER_DRAIN = false;
    bf16_t* O; int ldo;
    __device__ __forceinline__ void operator()(const f32x4 (&acc)[2][2][4][2], const Unit& u, int wr, int wc, int fr, int fq) const {
        const int row0 = u.pm * BM + wr * 64 + fr, col0 = u.pn * HALF + wc * 16 + 4 * fq;
#pragma unroll
        for (int ai = 0; ai < 2; ++ai)
#pragma unroll
            for (int m = 0; m < 4; ++m) { const size_t r = (size_t)(row0 + ai * HALF + m * 16);
#pragma unroll
                for (int bj = 0; bj < 2; ++bj) { const f32x4 g = acc[ai][bj][m][0], up = acc[ai][bj][m][1];
                    u32x2 w; w.x = cvt_pk_bf16(siluf_fast(g[0]) * up[0], siluf_fast(g[1]) * up[1]); w.y = cvt_pk_bf16(siluf_fast(g[2]) * up[2], siluf_fast(g[3]) * up[3]);
                    *(u32x2*)(O + r * ldo + col0 + bj * 64) = w; } }
    }
};
struct EpiPle {
    static constexpr bool PERM = false, AFTER_DRAIN = false;
    float* H; const bf16_t* E; int ld;
    __device__ __forceinline__ void operator()(const f32x4 (&acc)[2][2][4][2], const Unit& u, int wr, int wc, int fr, int fq) const {
        const int row0 = u.pm * BM + wr * 64 + fr, col0 = u.pn * BM + wc * 32 + 4 * fq;
#pragma unroll
        for (int ai = 0; ai < 2; ++ai)
#pragma unroll
            for (int m = 0; m < 4; ++m) { const size_t off = (size_t)(row0 + ai * HALF + m * 16) * ld + col0;
#pragma unroll
                for (int bj = 0; bj < 2; ++bj)
#pragma unroll
                    for (int n = 0; n < 2; ++n) { const size_t o = off + bj * HALF + n * 16;
                        const u32x2 ew = *(const u32x2*)(E + o); const f32x4 hv = *(const f32x4*)(H + o); const f32x4 a = acc[ai][bj][m][n];
                        f32x4 r; r[0] = hv[0] + sigmoidf_fast(a[0]) * bf_lo(ew.x); r[1] = hv[1] + sigmoidf_fast(a[1]) * bf_hi(ew.x); r[2] = hv[2] + sigmoidf_fast(a[2]) * bf_lo(ew.y); r[3] = hv[3] + sigmoidf_fast(a[3]) * bf_hi(ew.y);
                        *(f32x4*)(H + o) = r; }
                asm volatile("" ::: "memory"); }
    }
};

template <class Epi, class Sched, bool ALIGN_EPI = false, bool SP2 = false>
__device__ __forceinline__ void gemm_phase(PG8_LAS unsigned char* lds, const Gemm g, const Sched& S, const Epi& E, const int tid_in) {
    const int tid = tid_in, wid = __builtin_amdgcn_readfirstlane(tid >> 6), lane = tid & 63, wr = wid >> 2, wc = wid & 3, fr = lane & 15, fq = lane >> 4;
    const int K = g.K, nt = K / BK;
    unsigned voffA[2], voffB[2];
#pragma unroll
    for (int i = 0; i < 2; ++i) { int R, C; stage_rc(tid * 16 + i * 8192, R, C); const int Rb = Epi::PERM ? ((R & ~31) + perm32(R & 31)) : R;
        voffA[i] = (unsigned)(R * K + C) * 2u; voffB[i] = (unsigned)(Rb * K + C) * 2u; }
    const size_t kstep = (size_t)(BK * 2);
    const size_t hstep = (size_t)HALF * K * 2;
    const size_t tstep = 2 * hstep;
    const unsigned ldsw = (unsigned)wid * 1024u;
    const int aoff = lds_byte(wr * 64 + fr, fq * 8), boff = lds_byte(wc * 32 + fr, fq * 8);
#define PG8_SA(b, h) (((b) * 2 + (h)) * HTB)
#define PG8_SB(b, h) ((4 + (b) * 2 + (h)) * HTB)
#define PG8_STAGE(bufoff, gbase, voff) do { _Pragma("unroll") for (int _i = 0; _i < 2; ++_i) \
        __builtin_amdgcn_global_load_lds((const unsigned*)((const char*)(gbase) + (voff)[_i]), (PG8_LAS unsigned*)(lds + (bufoff) + ldsw + _i * 8192), 16, 0, 0); } while (0)
#define PG8_LDA(dst, b, h) do { _Pragma("unroll") for (int m = 0; m < 4; ++m) _Pragma("unroll") for (int k = 0; k < 2; ++k) dst[m][k] = *(const PG8_LAS bf16x8*)(lds + PG8_SA(b, h) + aoff + m * 2048 + k * 1024); } while (0)
#define PG8_LDB(dst, b, h) do { _Pragma("unroll") for (int n = 0; n < 2; ++n) _Pragma("unroll") for (int k = 0; k < 2; ++k) dst[n][k] = *(const PG8_LAS bf16x8*)(lds + PG8_SB(b, h) + boff + n * 2048 + k * 1024); } while (0)
#define PG8_MMA(ai, bj, At, Bt) do { __builtin_amdgcn_s_setprio(1); _Pragma("unroll") for (int m = 0; m < 4; ++m) _Pragma("unroll") for (int n = 0; n < 2; ++n) _Pragma("unroll") for (int k = 0; k < 2; ++k) \
        acc[ai][bj][m][n] = __builtin_amdgcn_mfma_f32_16x16x32_bf16(Bt[n][k], At[m][k], acc[ai][bj][m][n], 0, 0, 0); __builtin_amdgcn_s_setprio(0); } while (0)
#define PG8_WAIT_V(n) asm volatile("s_waitcnt vmcnt(" #n ")" ::: "memory")
#define PG8_WAIT_L(n) asm volatile("s_waitcnt lgkmcnt(" #n ")" ::: "memory")
#define PG8_BAR __builtin_amdgcn_s_barrier()
#define PG8_SCHED __builtin_amdgcn_sched_barrier(0)
    Unit cur, nxt; int ui = 0;
    if (!S.next(0, cur)) return;
    f32x4 acc[2][2][4][2];
#pragma unroll
    for (int a = 0; a < 2; ++a)
#pragma unroll
        for (int b = 0; b < 2; ++b)
#pragma unroll
            for (int m = 0; m < 4; ++m)
#pragma unroll
                for (int n = 0; n < 2; ++n) acc[a][b][m][n] = (f32x4){0.f, 0.f, 0.f, 0.f};
    bf16x8 At[4][2], B0[2][2], B1[2][2];
    const char* cA = (const char*)g.A + (size_t)cur.pm * tstep; const char* cB = (const char*)g.Bt + (size_t)cur.pn * tstep;
    S.a_ready(cur);
    if constexpr (SP2) {
        PG8_STAGE(PG8_SB(0, 0), cB, voffB); PG8_STAGE(PG8_SB(0, 1), cB + hstep, voffB); PG8_STAGE(PG8_SA(0, 0), cA, voffA); PG8_STAGE(PG8_SA(0, 1), cA + hstep, voffA);
        if (wr == 1) PG8_BAR;
        PG8_WAIT_V(2); PG8_BAR;
        PG8_STAGE(PG8_SB(1, 0), cB + kstep, voffB); PG8_STAGE(PG8_SA(1, 0), cA + kstep, voffA); PG8_STAGE(PG8_SB(1, 1), cB + hstep + kstep, voffB);
        PG8_WAIT_V(6); PG8_BAR;
    } else {
        PG8_STAGE(PG8_SB(0, 0), cB, voffB); PG8_STAGE(PG8_SA(0, 0), cA, voffA); PG8_STAGE(PG8_SB(0, 1), cB + hstep, voffB); PG8_STAGE(PG8_SA(0, 1), cA + hstep, voffA);
        if (wr == 1) PG8_BAR;
        PG8_WAIT_V(4); PG8_BAR;
        PG8_STAGE(PG8_SB(1, 0), cB + kstep, voffB); PG8_STAGE(PG8_SA(1, 0), cA + kstep, voffA); PG8_STAGE(PG8_SB(1, 1), cB + hstep + kstep, voffB);
        PG8_WAIT_V(6); PG8_BAR;
    }
    for (;;) {
        const bool has_next = S.next(ui + 1, nxt);
        const char* nA = has_next ? (const char*)g.A + (size_t)nxt.pm * tstep : cA; const char* nB = has_next ? (const char*)g.Bt + (size_t)nxt.pn * tstep : cB;
        for (int t = 0; t < nt; t += 2) {
            const bool last = (t == nt - 2);
            const char* a1 = cA + (size_t)(t + 1) * kstep;
            const char* a2 = last ? nA : cA + (size_t)(t + 2) * kstep; const char* b2 = last ? nB : cB + (size_t)(t + 2) * kstep;
            const char* a3 = a2 + kstep; const char* b3 = b2 + kstep;
            if (last && has_next) S.a_ready(nxt);
            if constexpr (SP2) {
            PG8_LDB(B0, 0, 0); PG8_LDB(B1, 0, 1); PG8_SCHED; PG8_LDA(At, 0, 0); PG8_STAGE(PG8_SA(1, 1), a1 + hstep, voffA);
            PG8_WAIT_V(8); PG8_WAIT_L(0); PG8_BAR; PG8_MMA(0, 0, At, B0); PG8_MMA(0, 1, At, B1); PG8_BAR; PG8_SCHED;
            PG8_LDA(At, 0, 1); PG8_STAGE(PG8_SB(0, 0), b2, voffB); PG8_STAGE(PG8_SB(0, 1), b2 + hstep, voffB); PG8_STAGE(PG8_SA(0, 0), a2, voffA);
            PG8_WAIT_V(8); PG8_WAIT_L(0); PG8_BAR; PG8_MMA(1, 0, At, B0); PG8_MMA(1, 1, At, B1); PG8_BAR; PG8_SCHED;
            PG8_LDB(B0, 1, 0); PG8_LDB(B1, 1, 1); PG8_SCHED; PG8_LDA(At, 1, 0); PG8_STAGE(PG8_SA(0, 1), a2 + hstep, voffA);
            PG8_WAIT_V(8); PG8_WAIT_L(0); PG8_BAR; PG8_MMA(0, 0, At, B0); PG8_MMA(0, 1, At, B1); PG8_BAR; PG8_SCHED;
            PG8_LDA(At, 1, 1); PG8_STAGE(PG8_SB(1, 0), b3, voffB); PG8_STAGE(PG8_SB(1, 1), b3 + hstep, voffB); PG8_STAGE(PG8_SA(1, 0), a3, voffA);
            PG8_WAIT_V(8); PG8_WAIT_L(0); PG8_BAR; PG8_MMA(1, 0, At, B0); PG8_MMA(1, 1, At, B1); PG8_BAR; PG8_SCHED;
            } else {
            PG8_LDB(B0, 0, 0); PG8_SCHED; PG8_LDA(At, 0, 0); PG8_STAGE(PG8_SA(1, 1), a1 + hstep, voffA);
            PG8_WAIT_L(8); PG8_BAR; PG8_WAIT_L(0); PG8_MMA(0, 0, At, B0); PG8_BAR; PG8_SCHED;
            PG8_LDB(B1, 0, 1); PG8_STAGE(PG8_SB(0, 0), b2, voffB);
            PG8_BAR; PG8_WAIT_L(0); PG8_MMA(0, 1, At, B1); PG8_BAR;
            PG8_LDA(At, 0, 1); PG8_STAGE(PG8_SA(0, 0), a2, voffA);
            PG8_BAR; PG8_WAIT_L(0); PG8_MMA(1, 0, At, B0); PG8_BAR; PG8_SCHED;
            PG8_STAGE(PG8_SB(0, 1), b2 + hstep, voffB);
            PG8_WAIT_V(6); PG8_BAR; PG8_MMA(1, 1, At, B1); PG8_BAR;
            PG8_LDB(B0, 1, 0); PG8_SCHED; PG8_LDA(At, 1, 0); PG8_STAGE(PG8_SA(0, 1), a2 + hstep, voffA);
            PG8_WAIT_L(8); PG8_BAR; PG8_WAIT_L(0); PG8_MMA(0, 0, At, B0); PG8_BAR; PG8_SCHED;
            PG8_LDB(B1, 1, 1); PG8_STAGE(PG8_SB(1, 0), b3, voffB);
            PG8_BAR; PG8_WAIT_L(0); PG8_MMA(0, 1, At, B1); PG8_BAR;
            PG8_LDA(At, 1, 1); PG8_STAGE(PG8_SA(1, 0), a3, voffA);
            PG8_BAR; PG8_WAIT_L(0); PG8_MMA(1, 0, At, B0); PG8_BAR; PG8_SCHED;
            PG8_STAGE(PG8_SB(1, 1), b3 + hstep, voffB);
            PG8_WAIT_V(6); PG8_BAR; PG8_MMA(1, 1, At, B1); PG8_BAR;
            }
        }
        if constexpr (ALIGN_EPI) { if (wr == 0) PG8_BAR; }
        if constexpr (!Epi::AFTER_DRAIN) { E(acc, cur, wr, wc, fr, fq); S.done(cur); }
        if (!has_next) break;
#pragma unroll
        for (int a = 0; a < 2; ++a)
#pragma unroll
            for (int b = 0; b < 2; ++b)
#pragma unroll
                for (int m = 0; m < 4; ++m)
#pragma unroll
                    for (int n = 0; n < 2; ++n) acc[a][b][m][n] = (f32x4){0.f, 0.f, 0.f, 0.f};
        cur = nxt; cA = nA; cB = nB; ++ui;
        if constexpr (ALIGN_EPI) { if (wr == 1) PG8_BAR; }
    }
    PG8_WAIT_V(0);
    if constexpr (!ALIGN_EPI) { if (wr == 0) PG8_BAR; }
    PG8_BAR;
    if constexpr (Epi::AFTER_DRAIN) { E.fused(acc, cur, wr, wc, fr, fq, lds, wid, lane); S.done(cur); }
#undef PG8_SA
#undef PG8_SB
#undef PG8_STAGE
#undef PG8_LDA
#undef PG8_LDB
#undef PG8_MMA
#undef PG8_WAIT_V
#undef PG8_WAIT_L
#undef PG8_BAR
#undef PG8_SCHED
}
}

#ifndef PG8_SP2
#define PG8_SP2 true
#endif
#ifndef PG8_ALIGN
#define PG8_ALIGN true
#endif
constexpr int NWAVES = 8;
constexpr int BATCH = 4, SEQ = 2048, D = 2048, DEPTH = 4, M = BATCH * SEQ;
constexpr int PLE = 256, SSD_INNER = 4096, HEADS = 64, HD = 64, GROUPS = 8, NSTATE = 128, XBC = 6144, DFF = 5632, DIN = 20544;
constexpr float EPS = 1e-6f;
constexpr int PC_Z = 0, PC_XBC = 4096, PC_SCB = 10240, PC_SCC = 12288, PC_SCX = 14336, PC_GA = 16384, PC_GB = 18432, PC_DT = 20480, NP = 20736;
constexpr size_t MiB = 1u << 20;
constexpr size_t WS_CTL = 0, CTL_ZERO_BYTES = 1 * MiB;
constexpr size_t WL_WIN = 0, WL_SSDOUT = 81 * MiB, WL_SCOUT = 97 * MiB, WL_WO = 105 * MiB, WL_WGU = 113 * MiB, WL_WDOWN = 157 * MiB, WL_PLEG = 179 * MiB, WL_PLEP = 187 * MiB, WL_STRIDE = 188 * MiB;
constexpr size_t WS_W = 1 * MiB;
constexpr size_t WS_XN = WS_W + 4 * WL_STRIDE;
constexpr size_t WS_PROJ = WS_XN + 32 * MiB;
constexpr size_t WS_ACT = WS_PROJ;
constexpr size_t WS_YG = WS_PROJ + 324 * MiB;
constexpr size_t WS_YSC = WS_YG + 64 * MiB;
constexpr size_t WS_T = WS_YSC + 32 * MiB;
constexpr size_t WS_MRG = WS_T + 64 * MiB;
constexpr size_t WS_H = WS_MRG + 32 * MiB;
constexpr size_t WS_E = WS_H + 64 * MiB;
constexpr size_t WS_PBF = WS_E + 32 * MiB;
constexpr size_t WS_SMALL = WS_PBF + 16 * MiB;
constexpr size_t WS_END = WS_SMALL + 1 * MiB;
constexpr int SM_NORM_MIX = 0, SM_NORM_FFN = SM_NORM_MIX + DEPTH * D, SM_NORM_PLE = SM_NORM_FFN + DEPTH * D, SM_NORM_FINAL = SM_NORM_PLE + DEPTH * D, SM_SSD_NORM = SM_NORM_FINAL + D,
              SM_CONV_W = SM_SSD_NORM + DEPTH * SSD_INNER, SM_CONV_B = SM_CONV_W + DEPTH * 4 * XBC, SM_DT_BIAS = SM_CONV_B + DEPTH * XBC, SM_A_LOG = SM_DT_BIAS + DEPTH * HEADS, SM_D = SM_A_LOG + DEPTH * HEADS,
              SM_SC_CONV_W = SM_D + DEPTH * HEADS, SM_END = SM_SC_CONV_W + DEPTH * 3 * D;
static_assert((size_t)SM_END * 4 <= 1 * MiB, "small-vector copies fit");
constexpr int CW_BAR = 4096;
constexpr int LDS_BYTES = 147456;
constexpr int RING_OFF = 0;
constexpr int MISC_OFF = LDS_BYTES - 256;

#define GAS __attribute__((address_space(1)))
#define LAS __attribute__((address_space(3)))
typedef unsigned short bf16;
typedef unsigned v4u __attribute__((ext_vector_type(4)));
typedef unsigned v2u __attribute__((ext_vector_type(2)));
typedef float f32x4 __attribute__((ext_vector_type(4)));
#define LDS_WAIT() asm volatile("s_waitcnt lgkmcnt(0)" ::: "memory")
#define VM_WAIT() asm volatile("s_waitcnt vmcnt(0)" ::: "memory")
__device__ __forceinline__ unsigned f2bf(float f) { unsigned u = __builtin_bit_cast(unsigned, f); return (u + 0x7fffu + ((u >> 16) & 1u)) >> 16; }
__device__ __forceinline__ unsigned pk2(float lo, float hi) { return pg8::cvt_pk_bf16(lo, hi); }
__device__ __forceinline__ float bf2f(bf16 b) { return __uint_as_float(((unsigned)b) << 16); }
__device__ __forceinline__ float blo(unsigned w) { return __uint_as_float(w << 16); }
__device__ __forceinline__ float bhi(unsigned w) { return __uint_as_float(w & 0xffff0000u); }
__device__ __forceinline__ float sigm(float x) { return 1.0f / (1.0f + __expf(-x)); }
__device__ __forceinline__ float silu(float x) { return x * sigm(x); }
__device__ __forceinline__ float softplus(float x) { return x > 20.f ? x : log1pf(__expf(x)); }

#define XB_TMO      128
#define XB_XCNT(j)  (256  + 64 * (j))
#define XB_XSUB(j)  (1280 + 64 * (j))
#define XB_XGEN(j)  (2304 + 64 * (j))
#define XB_TOP      3328
#define XB_TOPGEN   3392
#define XCD_BAR_WORDS 3456
#define XB_SPIN_CAP (1u << 18)

__device__ __forceinline__ unsigned xb_ld(unsigned* p)              { return __hip_atomic_load(p, __ATOMIC_RELAXED, __HIP_MEMORY_SCOPE_AGENT); }
__device__ __forceinline__ unsigned xb_add(unsigned* p, unsigned v) { return __hip_atomic_fetch_add(p, v, __ATOMIC_RELAXED, __HIP_MEMORY_SCOPE_AGENT); }
__device__ __forceinline__ unsigned xb_xcc_id() { return (unsigned)__builtin_amdgcn_s_getreg((3 << 11) | 20) & 0xFu; }
#define XB_SPIN(cond, bar) do { unsigned _sp = 0; while (cond) { __builtin_amdgcn_s_sleep(1); \
    if ((++_sp & 255u) == 0u) { if (xb_ld(&(bar)[XB_TMO])) break; if (_sp > XB_SPIN_CAP) { atomicAdd(&(bar)[XB_TMO], 1u); break; } } } } while (0)

struct XcdBarrier {
    unsigned* bar; unsigned x;
    volatile LAS unsigned* st;
};

__device__ __forceinline__ XcdBarrier xcd_barrier_post(unsigned* bar, volatile LAS unsigned* st) {
    XcdBarrier b; b.bar = bar; b.x = xb_xcc_id(); b.st = st;
    if (threadIdx.x == 0) (void)xb_add(&bar[XB_XCNT(b.x)], 1u);
    return b;
}
__device__ __forceinline__ void xcd_barrier_complete(unsigned* bar, unsigned x, unsigned& nloc, unsigned& nx) {
    const unsigned G = gridDim.x * gridDim.y * gridDim.z;
    unsigned sum, cnt, mine, sp = 0u;
    for (;;) {
        sum = 0u; cnt = 0u; mine = 0u;
#pragma unroll
        for (unsigned j = 0; j < 16; ++j) { const unsigned c = xb_ld(&bar[XB_XCNT(j)]); sum += c; cnt += (c > 0u) ? 1u : 0u; mine = (j == x) ? c : mine; }
        if (sum == G) break;
        __builtin_amdgcn_s_sleep(1);
        if ((++sp & 255u) == 0u) { if (xb_ld(&bar[XB_TMO])) break; if (sp > XB_SPIN_CAP) { atomicAdd(&bar[XB_TMO], 1u); break; } }
    }
    nloc = mine > 0u ? mine : 1u; nx = cnt > 0u ? cnt : 1u;
}

__device__ __forceinline__ void xcd_barrier(const XcdBarrier& b) {
    asm volatile("s_waitcnt vmcnt(0)" ::: "memory");
    __syncthreads();
    if (threadIdx.x == 0) {
        int zofs = 0; asm volatile("" : "+s"(zofs)); unsigned* bar = b.bar + zofs; const unsigned myx = xb_xcc_id();
        __builtin_amdgcn_s_waitcnt(0);
        unsigned nloc = b.st[0], nx = b.st[1];
        if (nloc == 0u) { xcd_barrier_complete(bar, myx, nloc, nx); b.st[0] = nloc; b.st[1] = nx; }
        const unsigned old = xb_add(&bar[XB_XSUB(myx)], 1u);
        const unsigned gen = old / nloc;
        if (old + 1u == (gen + 1u) * nloc) {
            __builtin_amdgcn_fence(__ATOMIC_RELEASE, "agent");
            asm volatile("s_waitcnt vmcnt(0)" ::: "memory");
            const unsigned og = xb_add(&bar[XB_TOP], 1u);
            const unsigned tg = og / nx;
            if (og + 1u == (tg + 1u) * nx) xb_add(&bar[XB_TOPGEN], 1u);
            else XB_SPIN(xb_ld(&bar[XB_TOPGEN]) == tg, bar);
            __builtin_amdgcn_fence(__ATOMIC_ACQUIRE, "agent");
            xb_add(&bar[XB_XGEN(myx)], 1u);
            asm volatile("s_waitcnt vmcnt(0)" ::: "memory");
        } else {
            XB_SPIN(xb_ld(&bar[XB_XGEN(myx)]) == gen, bar);
            __builtin_amdgcn_fence(__ATOMIC_ACQUIRE, "agent");
            asm volatile("s_waitcnt vmcnt(0)" ::: "memory");
        }
    }
    __syncthreads();
}
struct Params {
    const float *x, *p, *norm_mix, *w_in, *ssd_conv_w, *ssd_conv_b, *ssd_dt_bias, *ssd_a_log, *ssd_d, *ssd_norm, *ssd_out, *sc_conv_w, *sc_out, *w_o, *norm_ffn, *w_gate_up, *w_down, *norm_ple, *ple_gate, *ple_proj, *norm_final;
    float* out; unsigned char* ws;
};
static_assert(sizeof(Params) == 23 * 8, "Params has no padding");

__device__ __forceinline__ float wave_sum(float v) {
#pragma unroll
    for (int o = 1; o < 64; o <<= 1) v += __shfl_xor(v, o);
    return v;
}
__device__ __forceinline__ int rowmap(int mode, int n) {
    if (mode == 1) return n < 10240 ? n : (n < 10304 ? n + (PC_DT - 10240) : n - 64);
    if (mode == 2) { const int isup = n >= DFF ? 1 : 0; const int f = n - isup * DFF;
        return 256 * (f >> 7) + 128 * ((f >> 6) & 1) + 32 * ((f >> 4) & 3) + 16 * isup + (f & 15); }
    return n;
}
__device__ __forceinline__ void transpose_item(const float* W, int K, int N, bf16* WT, int mode, LAS float* scr, int item, int lane) {
    const int nblk = N / 32, kb = item / nblk, nb = item % nblk, k0 = 64 * kb, n0 = 32 * nb;
#pragma unroll 8
    for (int i = 0; i < 32; ++i) { const int kk = 2 * i + (lane >> 5); scr[kk * 33 + (lane & 31)] = W[(size_t)(k0 + kk) * N + n0 + (lane & 31)]; }
    LDS_WAIT(); asm volatile("" ::: "memory");
    const int c = lane & 7;
#pragma unroll
    for (int j = 0; j < 4; ++j) { const int n = (lane >> 3) + 8 * j; const LAS float* s = scr + (8 * c) * 33 + n;
        v4u o; o.x = pk2(s[0 * 33], s[1 * 33]); o.y = pk2(s[2 * 33], s[3 * 33]); o.z = pk2(s[4 * 33], s[5 * 33]); o.w = pk2(s[6 * 33], s[7 * 33]);
        *(v4u*)(WT + (size_t)rowmap(mode, n0 + n) * K + k0 + 8 * c) = o; }
    LDS_WAIT(); asm volatile("" ::: "memory");
}
constexpr int I_WIN = (D / 64) * (DIN / 32), I_SSDOUT = (SSD_INNER / 64) * (D / 32), I_SQ = (D / 64) * (D / 32), I_WGU = (D / 64) * (2 * DFF / 32), I_WDOWN = (DFF / 64) * (D / 32), I_PLEP = (PLE / 64) * (D / 32);
constexpr int I_LAYER = I_WIN + I_SSDOUT + 3 * I_SQ + I_WGU + I_WDOWN + I_PLEP;

__device__ __forceinline__ void prologue(const Params& P, LAS unsigned char* L, int gw, int NGW, int wave, int lane) {
    LAS float* scr = (LAS float*)(L + RING_OFF + wave * 16384);
    unsigned char* ws = P.ws;
#ifndef DBG_SKIP_TRANSPOSE
    for (int it = gw; it < DEPTH * I_LAYER; it += NGW) {
        const int layer = it / I_LAYER; int r = it - layer * I_LAYER;
        unsigned char* wl = ws + WS_W + (size_t)layer * WL_STRIDE;
        if (r < I_WIN) { transpose_item(P.w_in + (size_t)layer * D * DIN, D, DIN, (bf16*)(wl + WL_WIN), 1, scr, r, lane); continue; } r -= I_WIN;
        if (r < I_SSDOUT) { transpose_item(P.ssd_out + (size_t)layer * SSD_INNER * D, SSD_INNER, D, (bf16*)(wl + WL_SSDOUT), 0, scr, r, lane); continue; } r -= I_SSDOUT;
        if (r < I_SQ) { transpose_item(P.sc_out + (size_t)layer * D * D, D, D, (bf16*)(wl + WL_SCOUT), 0, scr, r, lane); continue; } r -= I_SQ;
        if (r < I_SQ) { transpose_item(P.w_o + (size_t)layer * D * D, D, D, (bf16*)(wl + WL_WO), 0, scr, r, lane); continue; } r -= I_SQ;
        if (r < I_WGU) { transpose_item(P.w_gate_up + (size_t)layer * D * 2 * DFF, D, 2 * DFF, (bf16*)(wl + WL_WGU), 2, scr, r, lane); continue; } r -= I_WGU;
        if (r < I_WDOWN) { transpose_item(P.w_down + (size_t)layer * DFF * D, DFF, D, (bf16*)(wl + WL_WDOWN), 0, scr, r, lane); continue; } r -= I_WDOWN;
        if (r < I_SQ) { transpose_item(P.ple_gate + (size_t)layer * D * D, D, D, (bf16*)(wl + WL_PLEG), 0, scr, r, lane); continue; } r -= I_SQ;
        transpose_item(P.ple_proj + (size_t)layer * PLE * D, PLE, D, (bf16*)(wl + WL_PLEP), 0, scr, r, lane);
    }
#endif
#ifndef DBG_SKIP_PADP
    { constexpr int PADV = (NP - DIN) * D * 2 / 16;
      const int gt = gw * 64 + lane, NT = NGW * 64;
      for (int i = gt; i < DEPTH * PADV; i += NT) { const int layer = i / PADV, j = i - layer * PADV;
          *((v4u*)(ws + WS_W + (size_t)layer * WL_STRIDE + WL_WIN + (size_t)DIN * D * 2) + j) = (v4u){0u, 0u, 0u, 0u}; }
      const f32x4* ps = (const f32x4*)P.p; v2u* pd = (v2u*)(ws + WS_PBF);
      for (int i = gt; i < DEPTH * M * PLE / 4; i += NT) { const f32x4 v = ps[i]; v2u o; o.x = pk2(v[0], v[1]); o.y = pk2(v[2], v[3]); pd[i] = o; }
      { const f32x4* xs = (const f32x4*)P.x; f32x4* hd = (f32x4*)(ws + WS_H); for (int i = gt; i < M * D / 4; i += NT) hd[i] = xs[i]; }
      float* sm = (float*)(ws + WS_SMALL);
#define SM_COPY(src, off, n) for (int i = gt; i < (n); i += NT) sm[(off) + i] = (src)[i]
      SM_COPY(P.norm_mix, SM_NORM_MIX, DEPTH * D); SM_COPY(P.norm_ffn, SM_NORM_FFN, DEPTH * D); SM_COPY(P.norm_ple, SM_NORM_PLE, DEPTH * D); SM_COPY(P.norm_final, SM_NORM_FINAL, D);
      SM_COPY(P.ssd_norm, SM_SSD_NORM, DEPTH * SSD_INNER); SM_COPY(P.ssd_conv_w, SM_CONV_W, DEPTH * 4 * XBC); SM_COPY(P.ssd_conv_b, SM_CONV_B, DEPTH * XBC);
      SM_COPY(P.ssd_dt_bias, SM_DT_BIAS, DEPTH * HEADS); SM_COPY(P.ssd_a_log, SM_A_LOG, DEPTH * HEADS); SM_COPY(P.ssd_d, SM_D, DEPTH * HEADS); SM_COPY(P.sc_conv_w, SM_SC_CONV_W, DEPTH * 3 * D);
#undef SM_COPY
    }
#endif
}
__device__ __forceinline__ void rmsnorm_row_bf16(const float* xrow, const float* g, bf16* orow, int lane) {
    const f32x4* xr = (const f32x4*)xrow + lane; f32x4 v[8]; float s = 0.f;
#pragma unroll
    for (int j = 0; j < 8; ++j) { v[j] = xr[64 * j]; s += (v[j][0] * v[j][0] + v[j][1] * v[j][1]) + (v[j][2] * v[j][2] + v[j][3] * v[j][3]); }
    const float rs = 1.0f / sqrtf(wave_sum(s) * (1.0f / D) + EPS);
    const f32x4* gr = (const f32x4*)g + lane; v2u* o8 = (v2u*)orow + lane;
#pragma unroll
    for (int j = 0; j < 8; ++j) { const f32x4 gv = gr[64 * j]; v2u o; o.x = pk2(v[j][0] * rs * gv[0], v[j][1] * rs * gv[1]); o.y = pk2(v[j][2] * rs * gv[2], v[j][3] * rs * gv[3]); o8[64 * j] = o; }
}
__device__ __forceinline__ void rmsnorm_row_f32(const float* xrow, const float* g, float* orow, int lane) {
    const f32x4* xr = (const f32x4*)xrow + lane; f32x4 v[8]; float s = 0.f;
#pragma unroll
    for (int j = 0; j < 8; ++j) { v[j] = xr[64 * j]; s += (v[j][0] * v[j][0] + v[j][1] * v[j][1]) + (v[j][2] * v[j][2] + v[j][3] * v[j][3]); }
    const float rs = 1.0f / sqrtf(wave_sum(s) * (1.0f / D) + EPS);
    const f32x4* gr = (const f32x4*)g + lane; f32x4* o = (f32x4*)orow + lane;
#pragma unroll
    for (int j = 0; j < 8; ++j) { const f32x4 gv = gr[64 * j]; o[64 * j] = v[j] * rs * gv; }
}

__device__ __forceinline__ void ssd_naive_phase(unsigned char* ws, LAS unsigned char* L, int layer, int tid) {
    const bf16* proj = (const bf16*)(ws + WS_PROJ); bf16* yg = (bf16*)(ws + WS_YG); const float* sm = (const float*)(ws + WS_SMALL);
    const float* cw = sm + SM_CONV_W + (size_t)layer * 4 * XBC; const float* cb = sm + SM_CONV_B + (size_t)layer * XBC;
    LAS float* XS = (LAS float*)(L + RING_OFF);
    LAS float* DT = XS + 64 * 320;
    for (int unit = blockIdx.x; unit < BATCH * HEADS; unit += gridDim.x) {
        const int b = unit >> 6, h = unit & 63, g = h >> 3;
        const float a = -__expf(sm[SM_A_LOG + layer * HEADS + h]), dtb = sm[SM_DT_BIAS + layer * HEADS + h], dsk = sm[SM_D + layer * HEADS + h];
        const int p = tid >> 3, n0 = (tid & 7) * 16;
        float s[16];
#pragma unroll
        for (int j = 0; j < 16; ++j) s[j] = 0.f;
        for (int t0 = 0; t0 < SEQ; t0 += 64) {
            __syncthreads();
            for (int e = tid; e < 64 * 320; e += NWAVES * 64) {
                const int tl = e / 320, cc = e - tl * 320;
                const int ch = cc < 64 ? h * 64 + cc : (cc < 192 ? SSD_INNER + g * 128 + (cc - 64) : SSD_INNER + GROUPS * NSTATE + g * 128 + (cc - 192));
                const int t = t0 + tl; float v = cb[ch];
#pragma unroll
                for (int k = 0; k < 4; ++k) { const int tt = t - 3 + k; if (tt >= 0) v += cw[k * XBC + ch] * bf2f(proj[(size_t)(b * SEQ + tt) * NP + PC_XBC + ch]); }
                XS[tl * 320 + cc] = silu(v);
            }
            if (tid < 64) DT[tid] = softplus(bf2f(proj[(size_t)(b * SEQ + t0 + tid) * NP + PC_DT + h]) + dtb);
            __syncthreads();
            for (int tl = 0; tl < 64; ++tl) {
                const float dt = DT[tl], dA = __expf(a * dt), xp = XS[tl * 320 + p], dtx = dt * xp;
                float yp = 0.f;
#pragma unroll
                for (int j = 0; j < 16; ++j) { s[j] = s[j] * dA + dtx * XS[tl * 320 + 64 + n0 + j]; yp += s[j] * XS[tl * 320 + 192 + n0 + j]; }
                yp += __shfl_xor(yp, 1); yp += __shfl_xor(yp, 2); yp += __shfl_xor(yp, 4);
                if ((tid & 7) == 0) { const size_t row = (size_t)(b * SEQ + t0 + tl);
                    const float y = (yp + dsk * xp) * silu(bf2f(proj[row * NP + PC_Z + h * 64 + p]));
                    yg[row * SSD_INNER + h * 64 + p] = (bf16)f2bf(y); }
            }
        }
    }
}
__device__ __forceinline__ void n2_phase(unsigned char* ws, int layer, int gw, int NGW, int lane) {
    const bf16* proj = (const bf16*)(ws + WS_PROJ); bf16* yg = (bf16*)(ws + WS_YG); bf16* ysc = (bf16*)(ws + WS_YSC); const float* sm = (const float*)(ws + WS_SMALL);
    const float* nw = sm + SM_SSD_NORM + (size_t)layer * SSD_INNER; const float* scw = sm + SM_SC_CONV_W + (size_t)layer * 3 * D;
    for (int row = gw; row < M; row += NGW) {
#pragma unroll 2
        for (int g = 0; g < GROUPS; ++g) {
            v4u* ptr = (v4u*)(yg + (size_t)row * SSD_INNER + g * 512 + lane * 8); const v4u w = *ptr;
            float v[8] = {blo(w.x), bhi(w.x), blo(w.y), bhi(w.y), blo(w.z), bhi(w.z), blo(w.w), bhi(w.w)};
            float ss = 0.f;
#pragma unroll
            for (int j = 0; j < 8; ++j) ss += v[j] * v[j];
            const float rs = 1.0f / sqrtf(wave_sum(ss) * (1.0f / 512.0f) + EPS);
            const f32x4 n0 = *(const f32x4*)(nw + g * 512 + lane * 8), n1 = *(const f32x4*)(nw + g * 512 + lane * 8 + 4);
            v4u o; o.x = pk2(v[0] * rs * n0[0], v[1] * rs * n0[1]); o.y = pk2(v[2] * rs * n0[2], v[3] * rs * n0[3]); o.z = pk2(v[4] * rs * n1[0], v[5] * rs * n1[1]); o.w = pk2(v[6] * rs * n1[2], v[7] * rs * n1[3]);
            *ptr = o;
        }
        const int t = row % SEQ;
#pragma unroll 1
        for (int q = 0; q < 4; ++q) {
            const int c = q * 512 + lane * 8; float acc[8];
#pragma unroll
            for (int j = 0; j < 8; ++j) acc[j] = 0.f;
#pragma unroll
            for (int k = 0; k < 3; ++k) { const int tt = t - 2 + k;
                if (tt >= 0) { const size_t r2 = (size_t)(row - 2 + k);
                    const v4u bw = *(const v4u*)(proj + r2 * NP + PC_SCB + c), xw = *(const v4u*)(proj + r2 * NP + PC_SCX + c);
                    const f32x4 w0 = *(const f32x4*)(scw + k * D + c), w1 = *(const f32x4*)(scw + k * D + c + 4);
                    acc[0] += w0[0] * (blo(bw.x) * blo(xw.x)); acc[1] += w0[1] * (bhi(bw.x) * bhi(xw.x)); acc[2] += w0[2] * (blo(bw.y) * blo(xw.y)); acc[3] += w0[3] * (bhi(bw.y) * bhi(xw.y));
                    acc[4] += w1[0] * (blo(bw.z) * blo(xw.z)); acc[5] += w1[1] * (bhi(bw.z) * bhi(xw.z)); acc[6] += w1[2] * (blo(bw.w) * blo(xw.w)); acc[7] += w1[3] * (bhi(bw.w) * bhi(xw.w)); } }
            const v4u cv = *(const v4u*)(proj + (size_t)row * NP + PC_SCC + c);
            v4u o; o.x = pk2(blo(cv.x) * acc[0], bhi(cv.x) * acc[1]); o.y = pk2(blo(cv.y) * acc[2], bhi(cv.y) * acc[3]); o.z = pk2(blo(cv.z) * acc[4], bhi(cv.z) * acc[5]); o.w = pk2(blo(cv.w) * acc[6], bhi(cv.w) * acc[7]);
            *(v4u*)(ysc + (size_t)row * D + c) = o;
        }
    }
}

typedef short bf16x8v __attribute__((ext_vector_type(8)));
typedef float f32x16 __attribute__((ext_vector_type(16)));
#define MFMA32(a, b, c) __builtin_amdgcn_mfma_f32_32x32x16_bf16((a), (b), (c), 0, 0, 0)
#define LBAR() do { asm volatile("s_waitcnt lgkmcnt(0)" ::: "memory"); __builtin_amdgcn_s_barrier(); asm volatile("" ::: "memory"); } while (0)
constexpr int SR_C = 0, SR_B = 32768, SR_BT = 65536, SR_XT = 98304, SR_S = 114688, SR_F = 131072;
__device__ __forceinline__ int swz(int row) { return (row ^ (row >> 3)) & 15; }
__device__ __forceinline__ int tile_off(int row, int chunk) { return row * 256 + ((chunk ^ swz(row)) << 4); }
__device__ __forceinline__ bf16x8v lds_frag(LAS unsigned char* L, int region, int row, int chunk) { return *(const LAS bf16x8v*)(L + region + tile_off(row, chunk)); }
__device__ __forceinline__ unsigned cvtpk(float lo, float hi) { return pg8::cvt_pk_bf16(lo, hi); }

template <int NR> __device__ __forceinline__ void load_rows(v4u (&raw)[NR], const bf16* colp, int tfirst) {
    long long off0 = (long long)tfirst * NP; asm volatile("" : "+v"(off0)); const bf16* p0 = colp + off0;
#pragma unroll
    for (int i = 0; i < NR; ++i) { raw[i] = (tfirst + i >= 0) ? *(const v4u*)(p0 + (size_t)i * NP) : (v4u){0u, 0u, 0u, 0u}; }
}
template <int NT> __device__ __forceinline__ void conv_item(const v4u (&raw)[NT + 3], const float* cw, const float* cb, int ch, const float (&sc)[NT], v4u (&nat)[NT], unsigned (&trn)[8][NT / 2]) {
#pragma unroll
    for (int wi = 0; wi < 4; ++wi) {
        float w0[4], w1[4];
#pragma unroll
        for (int k = 0; k < 4; ++k) { w0[k] = cw[k * XBC + ch + 2 * wi]; w1[k] = cw[k * XBC + ch + 2 * wi + 1]; }
        const float b0 = cb[ch + 2 * wi], b1 = cb[ch + 2 * wi + 1];
        float lo[NT + 3], hi[NT + 3];
#pragma unroll
        for (int i = 0; i < NT + 3; ++i) { lo[i] = blo(raw[i][wi]); hi[i] = bhi(raw[i][wi]); }
        float t0[NT], t1[NT];
#pragma unroll
        for (int j = 0; j < NT; ++j) {
            float v0 = b0 + w0[0] * lo[j] + w0[1] * lo[j + 1] + w0[2] * lo[j + 2] + w0[3] * lo[j + 3];
            float v1 = b1 + w1[0] * hi[j] + w1[1] * hi[j + 1] + w1[2] * hi[j + 2] + w1[3] * hi[j + 3];
            v0 = silu(v0); v1 = silu(v1);
            nat[j][wi] = cvtpk(v0, v1);
            t0[j] = v0 * sc[j]; t1[j] = v1 * sc[j];
        }
#pragma unroll
        for (int q = 0; q < NT / 2; ++q) { trn[2 * wi][q] = cvtpk(t0[2 * q], t0[2 * q + 1]); trn[2 * wi + 1][q] = cvtpk(t1[2 * q], t1[2 * q + 1]); }
    }
}

__device__ __forceinline__ void ssd_chunk_phase(unsigned char* ws, LAS unsigned char* L, int layer, int tid) {
    const bf16* proj = (const bf16*)(ws + WS_PROJ); bf16* yg = (bf16*)(ws + WS_YG); const float* sm = (const float*)(ws + WS_SMALL);
    const float* cw = sm + SM_CONV_W + (size_t)layer * 4 * XBC; const float* cb = sm + SM_CONV_B + (size_t)layer * XBC;
    const int w = __builtin_amdgcn_readfirstlane(tid >> 6);
    LAS float* FA = (LAS float*)(L + SR_F);
    LAS float* acs = FA; LAS float* eacs = FA + 128; LAS float* wdec = FA + 256; LAS float* dtv = FA + 384; LAS float* rdt = FA + 512; LAS float* edec = FA + 640;
    for (int unit = blockIdx.x; unit < BATCH * HEADS; unit += gridDim.x) {
        const int b = unit >> 6, hd = unit & 63, g = hd >> 3;
        const float a = -__expf(sm[SM_A_LOG + layer * HEADS + hd]), dtb = sm[SM_DT_BIAS + layer * HEADS + hd], dsk = sm[SM_D + layer * HEADS + hd];
        const bf16* seq = proj + (size_t)b * SEQ * NP;
#define SSD_LANE_CONSTS(T) const int lane = (T) & 63, r = lane & 31, h = lane >> 5; \
        const int vcb = (T) & 31, tgb = (T) >> 5, isC = vcb >> 4, vcl = vcb & 15, chBC = SSD_INNER + isC * (GROUPS * NSTATE) + g * NSTATE + 8 * vcl; \
        const int vcx = (T) & 7, tgx = (T) >> 3, chX = hd * HD + 8 * vcx
        const int lb = w >> 1, pb = w & 1;
        f32x16 S;
#pragma unroll
        for (int i = 0; i < 16; ++i) S[i] = 0.f;
        LBAR();
        { v4u z4 = (v4u){0u, 0u, 0u, 0u}; *(LAS v4u*)(L + SR_S + tid * 32) = z4; *(LAS v4u*)(L + SR_S + tid * 32 + 16) = z4; }
        v4u rawBC[11], rawX[5]; bf16 dtr0 = 0, dtr1 = 0;
#pragma unroll
        for (int i = 0; i < 11; ++i) rawBC[i] = (v4u){0u, 0u, 0u, 0u};
#pragma unroll
        for (int i = 0; i < 5; ++i) rawX[i] = (v4u){0u, 0u, 0u, 0u};
        for (int c = -1; c < SEQ / 128; ++c) {
            const int t0 = c * 128;
            int tl_ = tid; asm volatile("" : "+v"(tl_));
            SSD_LANE_CONSTS(tl_);
            if (c >= 0) {
            LBAR();
            if (w == 0) {
                const float d0 = softplus(bf2f(dtr0) + dtb), d1 = softplus(bf2f(dtr1) + dtb);
                const float a0 = a * d0, a1 = a * d1; float s = a0 + a1;
#pragma unroll
                for (int off = 1; off < 64; off <<= 1) { const float t = __shfl_up(s, off); if (lane >= off) s += t; }
                const float c1 = s, c0 = s - a1, tot = __shfl(s, 63);
                acs[2 * lane] = c0; acs[2 * lane + 1] = c1; eacs[2 * lane] = __expf(c0); eacs[2 * lane + 1] = __expf(c1);
                wdec[2 * lane] = __expf(tot - c0); wdec[2 * lane + 1] = __expf(tot - c1);
                dtv[2 * lane] = d0; dtv[2 * lane + 1] = d1; rdt[2 * lane] = 1.0f / d0; rdt[2 * lane + 1] = 1.0f / d1;
                if (lane == 0) edec[0] = __expf(tot);
            }
            LBAR();
            {
                float sc[8]; v4u nat[8]; unsigned trn[8][4];
                { const f32x4 s0 = *(const LAS f32x4*)(wdec + 8 * tgb), s1 = *(const LAS f32x4*)(wdec + 8 * tgb + 4);
                  sc[0] = s0[0]; sc[1] = s0[1]; sc[2] = s0[2]; sc[3] = s0[3]; sc[4] = s1[0]; sc[5] = s1[1]; sc[6] = s1[2]; sc[7] = s1[3]; }
                conv_item<8>(rawBC, cw, cb, chBC, sc, nat, trn);
                const int regn = isC ? SR_C : SR_B;
#pragma unroll
                for (int j = 0; j < 8; ++j) *(LAS v4u*)(L + regn + tile_off(8 * tgb + j, vcl)) = nat[j];
                if (!isC) {
#pragma unroll
                    for (int cc = 0; cc < 8; ++cc) *(LAS v4u*)(L + SR_BT + tile_off(8 * vcl + cc, tgb)) = (v4u){trn[cc][0], trn[cc][1], trn[cc][2], trn[cc][3]};
                }
            }
            {
                float sc2[2]; v4u nat2[2]; unsigned trn2[8][1];
                sc2[0] = dtv[2 * tgx]; sc2[1] = dtv[2 * tgx + 1];
                conv_item<2>(rawX, cw, cb, chX, sc2, nat2, trn2);
#pragma unroll
                for (int cc = 0; cc < 8; ++cc) *(LAS unsigned*)(L + SR_XT + tile_off(8 * vcx + cc, tgx >> 2) + 4 * (tgx & 3)) = trn2[cc][0];
            }
            }
            if (c + 1 < SEQ / 128) {
                load_rows<11>(rawBC, seq + PC_XBC + chBC, t0 + 128 + 8 * tgb - 3);
                load_rows<5>(rawX, seq + PC_XBC + chX, t0 + 128 + 2 * tgx - 3);
                if (w == 0) { dtr0 = seq[(size_t)(t0 + 128 + 2 * lane) * NP + PC_DT + hd]; dtr1 = seq[(size_t)(t0 + 128 + 2 * lane + 1) * NP + PC_DT + hd]; }
            }
            if (c < 0) continue;
            LBAR();
            v2u mp[2][4];
#pragma unroll
            for (int sbi = 0; sbi < 2; ++sbi) {
                const int sb = 2 * pb + sbi;
                if (sb <= lb) {
                    f32x16 G;
#pragma unroll
                    for (int i = 0; i < 16; ++i) G[i] = 0.f;
#pragma unroll
                    for (int ks = 0; ks < 8; ++ks) G = MFMA32(lds_frag(L, SR_B, 32 * sb + r, 2 * ks + h), lds_frag(L, SR_C, 32 * lb + r, 2 * ks + h), G);
                    const float al = acs[32 * lb + r]; const int lrow = 32 * lb + r;
#pragma unroll
                    for (int q = 0; q < 4; ++q) { const int s0 = 32 * sb + 8 * q + 4 * h; const f32x4 as = *(const LAS f32x4*)(acs + s0);
                        float mv[4];
#pragma unroll
                        for (int i = 0; i < 4; ++i) { const float e = __expf(fminf(al - as[i], 0.f)); mv[i] = (s0 + i <= lrow) ? G[4 * q + i] * e : 0.f; }
                        mp[sbi][q].x = cvtpk(mv[0], mv[1]); mp[sbi][q].y = cvtpk(mv[2], mv[3]); }
                }
            }
            f32x16 Y;
#pragma unroll
            for (int i = 0; i < 16; ++i) Y[i] = 0.f;
#pragma unroll
            for (int ks = 0; ks < 8; ++ks) Y = MFMA32(lds_frag(L, SR_C, 32 * lb + r, 2 * ks + h), lds_frag(L, SR_S, 32 * pb + r, 2 * ks + h), Y);
#pragma unroll
            for (int q = 0; q < 4; ++q) { const f32x4 ea = *(const LAS f32x4*)(eacs + 32 * lb + 8 * q + 4 * h);
#pragma unroll
                for (int i = 0; i < 4; ++i) Y[4 * q + i] *= ea[i]; }
            LBAR();
            bf16 zr[16];
            { long long zo = (long long)(t0 + 32 * lb + 4 * h) * NP + PC_Z + hd * HD + 32 * pb + r; asm volatile("" : "+v"(zo)); const bf16* zp = seq + zo;
#pragma unroll
              for (int i = 0; i < 16; ++i) zr[i] = zp[(size_t)((i & 3) + 8 * (i >> 2)) * NP]; }
#pragma unroll
            for (int sbi = 0; sbi < 2; ++sbi) { const int sb = 2 * pb + sbi;
                if (sb <= lb) {
#pragma unroll
                    for (int q = 0; q < 4; ++q) *(LAS v2u*)(L + SR_B + tile_off(32 * lb + r, 4 * sb + q) + 8 * h) = mp[sbi][q]; } }
            LBAR();
            for (int ks = 0; ks < 2 * (lb + 1); ++ks) Y = MFMA32(lds_frag(L, SR_B, 32 * lb + r, 2 * ks + h), lds_frag(L, SR_XT, 32 * pb + r, 2 * ks + h), Y);
            { long long yo = (long long)(b * SEQ + t0 + 32 * lb + 4 * h) * SSD_INNER + hd * HD + 32 * pb + r; asm volatile("" : "+v"(yo)); bf16* yp = yg + yo;
#pragma unroll
              for (int q = 0; q < 4; ++q) {
                const v2u xd = *(const LAS v2u*)(L + SR_XT + tile_off(32 * pb + r, 4 * lb + q) + 8 * h);
                const f32x4 rd = *(const LAS f32x4*)(rdt + 32 * lb + 8 * q + 4 * h);
                const float xv[4] = {blo(xd.x), bhi(xd.x), blo(xd.y), bhi(xd.y)};
#pragma unroll
                for (int i = 0; i < 4; ++i) {
                    const float y = (Y[4 * q + i] + dsk * xv[i] * rd[i]) * silu(bf2f(zr[4 * q + i]));
                    yp[(size_t)(8 * q + i) * SSD_INNER] = (bf16)f2bf(y); }
              } }
            { const float ed = edec[0];
#pragma unroll
              for (int i = 0; i < 16; ++i) S[i] *= ed;
#pragma unroll
              for (int ks = 0; ks < 8; ++ks) S = MFMA32(lds_frag(L, SR_BT, 32 * lb + r, 2 * ks + h), lds_frag(L, SR_XT, 32 * pb + r, 2 * ks + h), S);
#pragma unroll
              for (int q = 0; q < 4; ++q) { v2u o; o.x = cvtpk(S[4 * q], S[4 * q + 1]); o.y = cvtpk(S[4 * q + 2], S[4 * q + 3]);
                  *(LAS v2u*)(L + SR_S + tile_off(32 * pb + r, 4 * lb + q) + 8 * h) = o; } }
        }
    }
}
#ifndef DBG_STOP_AT
#define DBG_STOP_AT -1
#endif
#define DBG_STOP(k) do { if (DBG_STOP_AT == (k)) return; } while (0)
__device__ __forceinline__ int fresh_lane() { int l; asm volatile("v_mbcnt_lo_u32_b32 %0, -1, 0\n\tv_mbcnt_hi_u32_b32 %0, -1, %0" : "=v"(l)); return l; }
__device__ __forceinline__ int fresh_tid(int wave_s) { return wave_s * 64 + fresh_lane(); }
__device__ __forceinline__ int opaque_s(int v) { asm volatile("" : "+s"(v)); return v; }
__global__ void __launch_bounds__(NWAVES * 64, 2) trunk_fwd(Params P) {
    extern __shared__ __attribute__((aligned(16))) unsigned char lds[];
    LAS unsigned char* L = (LAS unsigned char*)lds;
    DBG_STOP(-2);
    volatile LAS unsigned* MISC = (volatile LAS unsigned*)(L + MISC_OFF);
    const int tid0 = threadIdx.x, lane0 = tid0 & 63, wave0 = __builtin_amdgcn_readfirstlane(tid0 >> 6);
    const int G = gridDim.x; const int bx = blockIdx.x; const int vcu = (G % 8 == 0) ? (bx % 8) * (G / 8) + bx / 8 : bx;
    const int gw0 = vcu * NWAVES + wave0, NGW = G * NWAVES;
    if (tid0 < 64) MISC[tid0] = 0u;
    __syncthreads();
    unsigned char* ws = P.ws;
    XcdBarrier bar = xcd_barrier_post((unsigned*)(ws + WS_CTL) + CW_BAR, MISC + 8);

    bf16* XN = (bf16*)(ws + WS_XN); bf16* PROJ = (bf16*)(ws + WS_PROJ); bf16* ACT = (bf16*)(ws + WS_ACT); bf16* YG = (bf16*)(ws + WS_YG); bf16* YSC = (bf16*)(ws + WS_YSC);
    float* T = (float*)(ws + WS_T); bf16* MRG = (bf16*)(ws + WS_MRG); float* H = (float*)(ws + WS_H); bf16* EB = (bf16*)(ws + WS_E); bf16* PBF = (bf16*)(ws + WS_PBF);

    prologue(P, L, gw0, NGW, wave0, lane0);
    xcd_barrier(bar);
    DBG_STOP(0);

    for (int layer = 0; layer < DEPTH; ++layer) {
#define GW() (opaque_s(vcu) * NWAVES + wave0)
        unsigned char* wl = ws + WS_W + (size_t)layer * WL_STRIDE;
        const float* sm = (const float*)(ws + WS_SMALL);
        { const int lane = fresh_lane(); for (int row = GW(); row < M; row += NGW) rmsnorm_row_bf16(H + (size_t)row * D, sm + SM_NORM_MIX + (size_t)layer * D, XN + (size_t)row * D, lane); }
        xcd_barrier(bar);
        DBG_STOP(1);
        { pg8::Gemm g{XN, (const bf16*)(wl + WL_WIN), M, NP, D}; pg8::StaticOrder S; S.init(M, NP, G, bx);
          pg8::EpiStoreBf16 E{PROJ, NP};
          pg8::gemm_phase<pg8::EpiStoreBf16, pg8::StaticOrder, PG8_ALIGN, PG8_SP2>(L + RING_OFF, g, S, E, fresh_tid(wave0)); }
        xcd_barrier(bar);
        DBG_STOP(2);
#ifdef SSD_NAIVE
        ssd_naive_phase(ws, L, layer, fresh_tid(wave0));
#else
        ssd_chunk_phase(ws, L, layer, fresh_tid(wave0));
#endif
        xcd_barrier(bar);
        DBG_STOP(3);
        n2_phase(ws, layer, GW(), NGW, fresh_lane());
        xcd_barrier(bar);
        DBG_STOP(4);
        { pg8::Gemm g{YG, (const bf16*)(wl + WL_SSDOUT), M, D, SSD_INNER}; pg8::StaticOrder S; S.init(M, D, G, bx);
          pg8::EpiGateMulF32 E{T, D, PROJ + PC_GA, NP};
          pg8::gemm_phase<pg8::EpiGateMulF32, pg8::StaticOrder, PG8_ALIGN, PG8_SP2>(L + RING_OFF, g, S, E, fresh_tid(wave0)); }
        __syncthreads();
        { pg8::Gemm g{YSC, (const bf16*)(wl + WL_SCOUT), M, D, D}; pg8::StaticOrder S; S.init(M, D, G, bx);
          pg8::EpiGateAddBf16 E{T, D, PROJ + PC_GB, NP, MRG, D};
          pg8::gemm_phase<pg8::EpiGateAddBf16, pg8::StaticOrder, PG8_ALIGN, PG8_SP2>(L + RING_OFF, g, S, E, fresh_tid(wave0)); }
        xcd_barrier(bar);
        DBG_STOP(5);
        { pg8::Gemm g{MRG, (const bf16*)(wl + WL_WO), M, D, D}; pg8::StaticOrder S; S.init(M, D, G, bx);
          pg8::EpiResidF32 E{H, H, D};
          pg8::gemm_phase<pg8::EpiResidF32, pg8::StaticOrder, PG8_ALIGN, PG8_SP2>(L + RING_OFF, g, S, E, fresh_tid(wave0)); }
        xcd_barrier(bar);
        DBG_STOP(6);
        { const int lane = fresh_lane(); for (int row = GW(); row < M; row += NGW) rmsnorm_row_bf16(H + (size_t)row * D, sm + SM_NORM_FFN + (size_t)layer * D, XN + (size_t)row * D, lane); }
        xcd_barrier(bar);
        DBG_STOP(7);
        { pg8::Gemm g{XN, (const bf16*)(wl + WL_WGU), M, 2 * DFF, D}; pg8::StaticOrder S; S.init(M, 2 * DFF, G, bx);
          pg8::EpiSwiGLU E{ACT, DFF};
          pg8::gemm_phase<pg8::EpiSwiGLU, pg8::StaticOrder, PG8_ALIGN, PG8_SP2>(L + RING_OFF, g, S, E, fresh_tid(wave0)); }
        xcd_barrier(bar);
        DBG_STOP(8);
        { pg8::Gemm g{ACT, (const bf16*)(wl + WL_WDOWN), M, D, DFF}; pg8::StaticOrder S; S.init(M, D, G, bx);
          pg8::EpiResidF32 E{H, H, D};
          pg8::gemm_phase<pg8::EpiResidF32, pg8::StaticOrder, PG8_ALIGN, PG8_SP2>(L + RING_OFF, g, S, E, fresh_tid(wave0)); }
        xcd_barrier(bar);
        DBG_STOP(9);
        { const int lane = fresh_lane(); for (int row = GW(); row < M; row += NGW) rmsnorm_row_bf16(H + (size_t)row * D, sm + SM_NORM_PLE + (size_t)layer * D, XN + (size_t)row * D, lane); }
        xcd_barrier(bar);
        DBG_STOP(10);
        { pg8::Gemm g{PBF + (size_t)layer * M * PLE, (const bf16*)(wl + WL_PLEP), M, D, PLE}; pg8::StaticOrder S; S.init(M, D, G, bx);
          pg8::EpiStoreBf16 E{EB, D};
          pg8::gemm_phase<pg8::EpiStoreBf16, pg8::StaticOrder, PG8_ALIGN, PG8_SP2>(L + RING_OFF, g, S, E, fresh_tid(wave0)); }
        __syncthreads();
        { pg8::Gemm g{XN, (const bf16*)(wl + WL_PLEG), M, D, D}; pg8::StaticOrder S; S.init(M, D, G, bx);
          pg8::EpiPle E{H, EB, D};
          pg8::gemm_phase<pg8::EpiPle, pg8::StaticOrder, PG8_ALIGN, PG8_SP2>(L + RING_OFF, g, S, E, fresh_tid(wave0)); }
        xcd_barrier(bar);
    }
    { const int lane = fresh_lane();
      for (int row = gw0; row < M; row += NGW) rmsnorm_row_f32(H + (size_t)row * D, (const float*)(ws + WS_SMALL) + SM_NORM_FINAL, P.out + (size_t)row * D, lane); }
}

extern "C" void kernel_launch(void* const* d_in, const int* in_sizes, int n_in, void* d_out, int out_size, void* d_ws, size_t ws_size, hipStream_t stream) {
    static int grid = 0;
    if (grid == 0) {
        if (n_in != 21 || in_sizes[0] != M * D || out_size != M * D || ws_size < WS_END) { fprintf(stderr, "kernel_launch: unexpected shapes (n_in %d, in0 %d, out %d, ws %zu; need ws >= %zu); nothing launched\n", n_in, n_in > 0 ? in_sizes[0] : -1, out_size, ws_size, (size_t)WS_END); grid = -1; return; }
        int dev = 0, cus = 0, per_cu = 0;
        if (hipGetDevice(&dev) != hipSuccess || hipDeviceGetAttribute(&cus, hipDeviceAttributeMultiprocessorCount, dev) != hipSuccess) { fprintf(stderr, "kernel_launch: device query failed\n"); grid = -1; return; }
        if (hipFuncSetAttribute((const void*)trunk_fwd, hipFuncAttributeMaxDynamicSharedMemorySize, LDS_BYTES) != hipSuccess) { fprintf(stderr, "kernel_launch: hipFuncSetAttribute failed\n"); grid = -1; return; }
        if (hipOccupancyMaxActiveBlocksPerMultiprocessor(&per_cu, (const void*)trunk_fwd, NWAVES * 64, LDS_BYTES) != hipSuccess || per_cu < 1)
            fprintf(stderr, "kernel_launch: note: occupancy query reports %d workgroups per CU\n", per_cu);
        (void)hipGetLastError();
        grid = cus;
    }
    if (grid < 0) return;
    if (hipMemsetAsync((char*)d_ws + WS_CTL, 0, CTL_ZERO_BYTES, stream) != hipSuccess) { fprintf(stderr, "kernel_launch: memset failed\n"); return; }
    Params a{};
    a.x = (const float*)d_in[0]; a.p = (const float*)d_in[1]; a.norm_mix = (const float*)d_in[2]; a.w_in = (const float*)d_in[3]; a.ssd_conv_w = (const float*)d_in[4]; a.ssd_conv_b = (const float*)d_in[5];
    a.ssd_dt_bias = (const float*)d_in[6]; a.ssd_a_log = (const float*)d_in[7]; a.ssd_d = (const float*)d_in[8]; a.ssd_norm = (const float*)d_in[9]; a.ssd_out = (const float*)d_in[10]; a.sc_conv_w = (const float*)d_in[11];
    a.sc_out = (const float*)d_in[12]; a.w_o = (const float*)d_in[13]; a.norm_ffn = (const float*)d_in[14]; a.w_gate_up = (const float*)d_in[15]; a.w_down = (const float*)d_in[16]; a.norm_ple = (const float*)d_in[17];
    a.ple_gate = (const float*)d_in[18]; a.ple_proj = (const float*)d_in[19]; a.norm_final = (const float*)d_in[20];
    a.out = (float*)d_out; a.ws = (unsigned char*)d_ws;
    hipLaunchKernelGGL(trunk_fwd, dim3(grid), dim3(NWAVES * 64), LDS_BYTES, stream, a);
    const hipError_t le = hipPeekAtLastError();
    if (le != hipSuccess) fprintf(stderr, "kernel_launch: launch failed: %s\n", hipGetErrorName(le));
}
```
